# Optimizing an MI355X kernel written in HIP

```python
import math
import jax, jax.numpy as jnp
from jax import lax
import numpy as np

D_MODEL = 2048
BATCH = 2
SEQ = 8192
DEPTH = 2

A_HEADS = 8
A_HALF = 64
A_VDIM = 2 * A_HALF
LRU_WIDTH = 1024
LRU_BLOCKS = 8
LRU_BDIM = LRU_WIDTH // LRU_BLOCKS
CONV_WIDTH = 4
LRU_C = 8.0
C_HEADS = 8
C_HDIM = 128
N_BRANCH = 3
BRANCH_WIDTH = 1024
REL_BUCKETS = 32
REL_MAX_DIST = 128
Q_BLOCK = 128
PEER_HEADS = 8
PEER_NKEYS = 128
PEER_EXPERTS = PEER_NKEYS * PEER_NKEYS
PEER_QDIM = 128
PEER_HALF = PEER_QDIM // 2
PEER_TOPK = 16
PEER_CHUNK = 128
PLE_DIM = 256
DEEPNORM_ALPHA = (2 * DEPTH) ** 0.25
DEEPNORM_BETA = (8 * DEPTH) ** -0.25
LN_EPS = 1e-5

IN_SIZES = (
    A_HEADS * 2 * A_HALF,
    A_HEADS * 2 * A_HALF,
    A_HEADS * A_VDIM,
    LRU_WIDTH,
    LRU_WIDTH,
    C_HEADS * C_HDIM,
    C_HEADS * C_HDIM,
    C_HEADS * C_HDIM,
    C_HEADS,
    N_BRANCH * D_MODEL,
)
IN_TOTAL = sum(IN_SIZES)

kernel_name = "hybrid_diffattn_rglru_fox_peer_deepnorm"


def _split(t, sizes):
    outs, start = [], 0
    for n in sizes:
        outs.append(t[..., start:start + n])
        start += n
    return outs


def _layer_norm(x, g, b):
    xf = x.astype(jnp.float32)
    mu = jnp.mean(xf, axis=-1, keepdims=True)
    var = jnp.mean(jnp.square(xf - mu), axis=-1, keepdims=True)
    y = (xf - mu) * lax.rsqrt(var + LN_EPS)
    return (y * g.astype(jnp.float32) + b.astype(jnp.float32)).astype(x.dtype)


def _rms_norm(x, g):
    xf = x.astype(jnp.float32)
    y = xf * lax.rsqrt(jnp.mean(jnp.square(xf), axis=-1, keepdims=True) + LN_EPS)
    return y * g.astype(jnp.float32)


def _rel_bucket(rel):
    n = jnp.maximum(rel, 0)
    max_exact = REL_BUCKETS // 2
    nf = jnp.maximum(n, 1).astype(jnp.float32)
    large = max_exact + (jnp.log(nf / max_exact) / math.log(REL_MAX_DIST / max_exact)
                         * (REL_BUCKETS - max_exact)).astype(jnp.int32)
    large = jnp.minimum(large, REL_BUCKETS - 1)
    return jnp.where(n < max_exact, n, large)


def _diff_attention(q, k, v, rel_table, lam):
    B, S = q.shape[0], q.shape[1]
    nb = S // Q_BLOCK
    scale = A_HALF ** -0.5
    kpos = jnp.arange(S)

    def block(i):
        start = i * Q_BLOCK
        qb = lax.dynamic_slice_in_dim(q, start, Q_BLOCK, axis=1)
        qpos = start + jnp.arange(Q_BLOCK)
        rel = qpos[:, None] - kpos[None, :]
        bias = jnp.transpose(rel_table[_rel_bucket(rel)], (2, 0, 1)).astype(jnp.float32)
        logits = jnp.einsum('bqhcd,bkhcd->bhcqk', qb, k).astype(jnp.float32) * scale
        logits = logits + bias[None, :, None]
        logits = jnp.where(rel >= 0, logits, -jnp.inf)
        probs = jax.nn.softmax(logits, axis=-1)
        attn = probs[:, :, 0] - lam * probs[:, :, 1]
        return jnp.einsum('bhqk,bkhd->bqhd', attn.astype(v.dtype), v)

    out = lax.map(block, jnp.arange(nb))
    return jnp.transpose(out, (1, 0, 2, 3, 4)).reshape(B, S, A_HEADS, A_VDIM)


def _forgetting_attention(q, k, v, logf):
    B, S = q.shape[0], q.shape[1]
    nb = S // Q_BLOCK
    scale = C_HDIM ** -0.5
    cum = jnp.transpose(jnp.cumsum(logf, axis=1), (0, 2, 1))
    kpos = jnp.arange(S)

    def block(i):
        start = i * Q_BLOCK
        qb = lax.dynamic_slice_in_dim(q, start, Q_BLOCK, axis=1)
        cq = lax.dynamic_slice_in_dim(cum, start, Q_BLOCK, axis=2)
        qpos = start + jnp.arange(Q_BLOCK)
        causal = qpos[:, None] >= kpos[None, :]
        logits = jnp.einsum('bqhd,bkhd->bhqk', qb, k).astype(jnp.float32) * scale
        logits = logits + cq[..., None] - cum[:, :, None, :]
        logits = jnp.where(causal, logits, -jnp.inf)
        probs = jax.nn.softmax(logits, axis=-1)
        return jnp.einsum('bhqk,bkhd->bqhd', probs.astype(v.dtype), v)

    out = lax.map(block, jnp.arange(nb))
    return jnp.transpose(out, (1, 0, 2, 3, 4)).reshape(B, S, C_HEADS * C_HDIM)


def _causal_conv(x, w, b):
    S = x.shape[1]
    xp = jnp.pad(x, ((0, 0), (CONV_WIDTH - 1, 0), (0, 0)))
    y = b
    for tap in range(CONV_WIDTH):
        y = y + xp[:, tap:tap + S] * w[tap]
    return y


def _rg_lru(x, w_a, b_a, w_x, b_x, lam):
    B, S, W = x.shape
    xb = x.reshape(B, S, LRU_BLOCKS, LRU_BDIM)
    r = jax.nn.sigmoid(jnp.einsum('bsgi,gij->bsgj', xb, w_a).reshape(B, S, W) + b_a)
    gi = jax.nn.sigmoid(jnp.einsum('bsgi,gij->bsgj', xb, w_x).reshape(B, S, W) + b_x)
    log_a = LRU_C * r.astype(jnp.float32) * jax.nn.log_sigmoid(lam.astype(jnp.float32))
    a = jnp.exp(log_a)
    u = jnp.sqrt(-jnp.expm1(2.0 * log_a)) * (gi * x).astype(jnp.float32)

    def combine(left, right):
        a1, b1 = left
        a2, b2 = right
        return a1 * a2, a2 * b1 + b2

    _, h = lax.associative_scan(combine, (a, u), axis=1)
    return h.astype(x.dtype)


def _peer(x, w_q, sub_keys, u_tab, v_tab):
    B, S, D = x.shape
    xt = x.reshape((B * S) // PEER_CHUNK, PEER_CHUNK, D)

    def chunk(xc):
        q = (xc @ w_q).reshape(PEER_CHUNK, PEER_HEADS, 2, PEER_HALF)
        s = jnp.einsum('chpd,hpnd->chpn', q, sub_keys).astype(jnp.float32)
        s1, i1 = lax.top_k(s[:, :, 0], PEER_TOPK)
        s2, i2 = lax.top_k(s[:, :, 1], PEER_TOPK)
        cand = (s1[..., :, None] + s2[..., None, :]).reshape(PEER_CHUNK, PEER_HEADS, PEER_TOPK * PEER_TOPK)
        cidx = (i1[..., :, None] * PEER_NKEYS + i2[..., None, :]).reshape(PEER_CHUNK, PEER_HEADS, PEER_TOPK * PEER_TOPK)
        sc, pos = lax.top_k(cand, PEER_TOPK)
        idx = jnp.take_along_axis(cidx, pos, axis=-1)
        g = jax.nn.softmax(sc, axis=-1)
        ue = u_tab[idx]
        ve = v_tab[idx]
        act = jax.nn.gelu(jnp.einsum('chkd,cd->chk', ue, xc).astype(jnp.float32), approximate=False)
        return jnp.einsum('chk,chkd->cd', (g * act).astype(x.dtype), ve)

    return lax.map(chunk, xt).reshape(B, S, D)


def setup_inputs(seed: int = 0) -> dict:
    key = jax.random.key(seed)
    ks = jax.random.split(key, 32)
    f32 = jnp.float32

    def nrm(k, shape, scale):
        return jax.random.normal(k, shape, f32) * scale

    s = jax.random.uniform(ks[13], (DEPTH, LRU_WIDTH), f32, minval=0.9, maxval=0.999) ** (1.0 / LRU_C)
    return {
        "x": nrm(ks[0], (BATCH, SEQ, D_MODEL), 1.0),
        "p": nrm(ks[1], (DEPTH, BATCH, SEQ, PLE_DIM), 1.0),
        "w_in": nrm(ks[2], (DEPTH, D_MODEL, IN_TOTAL), D_MODEL ** -0.5),
        "b_in": nrm(ks[3], (DEPTH, IN_TOTAL), 0.02),
        "diff_lambda": nrm(ks[4], (DEPTH, 4, A_HALF), 0.1),
        "diff_subln": 1.0 + nrm(ks[5], (DEPTH, A_VDIM), 0.02),
        "rel_bias": nrm(ks[6], (REL_BUCKETS, A_HEADS), 0.5),
        "conv_w": nrm(ks[7], (DEPTH, CONV_WIDTH, LRU_WIDTH), CONV_WIDTH ** -0.5),
        "conv_b": nrm(ks[8], (DEPTH, LRU_WIDTH), 0.02),
        "lru_wa": nrm(ks[9], (DEPTH, LRU_BLOCKS, LRU_BDIM, LRU_BDIM), LRU_BDIM ** -0.5),
        "lru_ba": nrm(ks[10], (DEPTH, LRU_WIDTH), 0.02),
        "lru_wx": nrm(ks[11], (DEPTH, LRU_BLOCKS, LRU_BDIM, LRU_BDIM), LRU_BDIM ** -0.5),
        "lru_bx": nrm(ks[12], (DEPTH, LRU_WIDTH), 0.02),
        "lru_lambda": jnp.log(s) - jnp.log1p(-s),
        "w_branch": nrm(ks[14], (DEPTH, N_BRANCH, BRANCH_WIDTH, D_MODEL), DEEPNORM_BETA * BRANCH_WIDTH ** -0.5),
        "w_o": nrm(ks[15], (DEPTH, D_MODEL, D_MODEL), DEEPNORM_BETA * D_MODEL ** -0.5),
        "ln1_g": 1.0 + nrm(ks[16], (DEPTH, D_MODEL), 0.02),
        "ln1_b": nrm(ks[17], (DEPTH, D_MODEL), 0.02),
        "peer_wq": nrm(ks[18], (DEPTH, D_MODEL, PEER_HEADS * PEER_QDIM), D_MODEL ** -0.5),
        "peer_keys": nrm(ks[19], (DEPTH, PEER_HEADS, 2, PEER_NKEYS, PEER_HALF), PEER_HALF ** -0.5),
        "peer_u": nrm(ks[20], (DEPTH, PEER_EXPERTS, D_MODEL), D_MODEL ** -0.5),
        "peer_v": nrm(ks[21], (DEPTH, PEER_EXPERTS, D_MODEL), DEEPNORM_BETA),
        "w_ple": nrm(ks[22], (DEPTH, PLE_DIM, D_MODEL), DEEPNORM_BETA * PLE_DIM ** -0.5),
        "w_ple_gate": nrm(ks[23], (DEPTH, D_MODEL, D_MODEL), D_MODEL ** -0.5),
        "b_ple_gate": nrm(ks[24], (DEPTH, D_MODEL), 0.02),
        "ln2_g": 1.0 + nrm(ks[25], (DEPTH, D_MODEL), 0.02),
        "ln2_b": nrm(ks[26], (DEPTH, D_MODEL), 0.02),
    }


def reference(x, p, w_in, b_in, diff_lambda, diff_subln, rel_bias, conv_w, conv_b,
              lru_wa, lru_ba, lru_wx, lru_bx, lru_lambda, w_branch, w_o, ln1_g, ln1_b,
              peer_wq, peer_keys, peer_u, peer_v, w_ple, w_ple_gate, b_ple_gate,
              ln2_g, ln2_b):
    B, S, D = x.shape
    for i in range(DEPTH):
        h = x @ w_in[i] + b_in[i]
        qa, ka, va, bx, bg, qc, kc, vc, fc, gt = _split(h, IN_SIZES)

        lam_init = 0.8 - 0.6 * math.exp(-0.3 * i)
        lv = diff_lambda[i].astype(jnp.float32)
        lam = jnp.exp(jnp.sum(lv[0] * lv[1])) - jnp.exp(jnp.sum(lv[2] * lv[3])) + lam_init
        ya = _diff_attention(qa.reshape(B, S, A_HEADS, 2, A_HALF),
                             ka.reshape(B, S, A_HEADS, 2, A_HALF),
                             va.reshape(B, S, A_HEADS, A_VDIM), rel_bias, lam)
        ya = (_rms_norm(ya, diff_subln[i]) * (1.0 - lam_init)).astype(x.dtype).reshape(B, S, BRANCH_WIDTH)

        xc = _causal_conv(bx, conv_w[i], conv_b[i])
        yb = jax.nn.gelu(bg) * _rg_lru(xc, lru_wa[i], lru_ba[i], lru_wx[i], lru_bx[i], lru_lambda[i])

        logf = jax.nn.log_sigmoid(fc.astype(jnp.float32))
        yc = _forgetting_attention(qc.reshape(B, S, C_HEADS, C_HDIM),
                                   kc.reshape(B, S, C_HEADS, C_HDIM),
                                   vc.reshape(B, S, C_HEADS, C_HDIM), logf)

        gate = jax.nn.sigmoid(gt.reshape(B, S, N_BRANCH, D))
        merged = (gate[:, :, 0] * (ya @ w_branch[i, 0])
                  + gate[:, :, 1] * (yb @ w_branch[i, 1])
                  + gate[:, :, 2] * (yc @ w_branch[i, 2]))
        x = _layer_norm(DEEPNORM_ALPHA * x + merged @ w_o[i], ln1_g[i], ln1_b[i])

        ple = jax.nn.sigmoid(x @ w_ple_gate[i] + b_ple_gate[i]) * (p[i] @ w_ple[i])
        yf = _peer(x, peer_wq[i], peer_keys[i], peer_u[i], peer_v[i])
        x = _layer_norm(DEEPNORM_ALPHA * x + yf + ple, ln2_g[i], ln2_b[i])
    return x
```

```cpp
#include <hip/hip_runtime.h>
#include <cstdio>
#include <cstdint>
namespace pg8 {
#define PG8_LAS __attribute__((address_space(3)))
typedef unsigned short bf16_t;
typedef short bf16x8 __attribute__((ext_vector_type(8)));
typedef float f32x4 __attribute__((ext_vector_type(4)));
typedef unsigned u32x4 __attribute__((ext_vector_type(4)));
constexpr int BM = 256, BK = 64, HALF = 128, HTB = HALF * BK * 2  , STAGE_BYTES = 8 * HTB, NXCD = 8, WGM = 8;

__host__ __device__ __forceinline__ int lds_byte(int r, int c) { const int st = (r >> 4) * 2 + (c >> 5), rr = r & 15, cc = c & 31, ob = rr * 64 + cc * 2; return st * 1024 + (ob ^ (((ob >> 9) & 1) << 5)); }
__host__ __device__ __forceinline__ void stage_rc(int b, int& R, int& C) { const int st = b / 1024, sb = b % 1024, swz = sb ^ (((sb >> 9) & 1) << 5); R = (st >> 1) * 16 + swz / 64; C = (st & 1) * 32 + (swz % 64) / 2; }
__host__ __device__ __forceinline__ int perm32(int rho) { const int n = rho >> 4, i = rho & 15; return 8 * (i >> 2) + 4 * n + (i & 3); }

struct Unit { int pm, pn, z; };
struct Gemm { const bf16_t* A; const bf16_t* Bt; int M, N, K; size_t zA, zB; };

struct StaticOrder {
    int nM, nN, nwg, G, c;
    __host__ __device__ void init(int M, int N, int G_, int c_) { nM = M / BM; nN = N / BM; nwg = nM * nN; G = G_; c = c_; }
    __host__ __device__ bool next(int i, Unit& u) const {
        const long L = (long)i * G + c; if (L >= nwg) return false;
        int wgid = (int)L; { const int q = nwg / NXCD, r = nwg % NXCD, xcd = wgid % NXCD, off = wgid / NXCD; wgid = (xcd < r ? xcd * (q + 1) : r * (q + 1) + (xcd - r) * q) + off; }
        const int nig = WGM * nN, gid = wgid / nig, fm = gid * WGM, gsz = (nM - fm) < WGM ? (nM - fm) : WGM;
        u.pm = fm + ((wgid % nig) % gsz); u.pn = (wgid % nig) / gsz; u.z = 0; return true;
    }
    __device__ __forceinline__ void a_ready(const Unit&) const {}
    __device__ __forceinline__ void done(const Unit&) const {}
};

__device__ __forceinline__ unsigned cvt_pk_bf16(float lo, float hi) { unsigned r; asm volatile("v_cvt_pk_bf16_f32 %0, %1, %2" : "=v"(r) : "v"(lo), "v"(hi)); return r; }
typedef float f32x2 __attribute__((ext_vector_type(2)));
__device__ __forceinline__ f32x2 gelu_pk(f32x2 v) {
    const f32x2 av = __builtin_elementwise_abs(v), d = av * 0.2316418882f + 1.0f;
    f32x2 t; t.x = __builtin_amdgcn_rcpf(d.x); t.y = __builtin_amdgcn_rcpf(d.y);
    f32x2 q = t * 0.5307027145f + (-0.7265760135f); q = q * t + 0.7107068705f; q = q * t + (-0.142248368f); q = q * t + 0.127414796f; q = q * t;
    const f32x2 s = (v * v) * (-0.72134752044f);
    f32x2 e; e.x = __builtin_amdgcn_exp2f(s.x); e.y = __builtin_amdgcn_exp2f(s.y);
    const f32x2 m = v * (q * e), r = v - m;
    f32x2 o; o.x = v.x < 0.f ? m.x : r.x; o.y = v.y < 0.f ? m.y : r.y; return o;
}


typedef int pg8_i32x8 __attribute__((ext_vector_type(8)));
typedef short pg8_bf16x16 __attribute__((ext_vector_type(16)));
typedef int pg8_i32x4 __attribute__((ext_vector_type(4)));
template <bool FP8>
__device__ __forceinline__ f32x4 mma_tile(const bf16x8 b0, const bf16x8 b1, const bf16x8 a0, const bf16x8 a1, f32x4 c) {
    if constexpr (FP8) { const pg8_i32x4 bl = __builtin_bit_cast(pg8_i32x4, b0), bh = __builtin_bit_cast(pg8_i32x4, b1), al = __builtin_bit_cast(pg8_i32x4, a0), ah = __builtin_bit_cast(pg8_i32x4, a1);
        pg8_i32x8 B_, A_; B_[0] = bl[0]; B_[1] = bl[1]; B_[2] = bl[2]; B_[3] = bl[3]; B_[4] = bh[0]; B_[5] = bh[1]; B_[6] = bh[2]; B_[7] = bh[3];
        A_[0] = al[0]; A_[1] = al[1]; A_[2] = al[2]; A_[3] = al[3]; A_[4] = ah[0]; A_[5] = ah[1]; A_[6] = ah[2]; A_[7] = ah[3];
        return __builtin_amdgcn_mfma_scale_f32_16x16x128_f8f6f4(B_, A_, c, 0, 0, 0, 0x79797979, 0, 0x7F7F7F7F); }
    else { c = __builtin_amdgcn_mfma_f32_16x16x32_bf16(b0, a0, c, 0, 0, 0); return __builtin_amdgcn_mfma_f32_16x16x32_bf16(b1, a1, c, 0, 0, 0); }
}
template <class Epi, class Sched, bool ALIGN_EPI = false, bool SP2 = false, bool FP8 = false, int SCB = 0x79, int SCA = 0x7F>
__device__ __forceinline__ void gemm_phase(PG8_LAS unsigned char* lds, const Gemm g, const Sched& S, const Epi& E) {
    int tid = threadIdx.x; asm volatile("" : "+v"(tid));
    const int wid = __builtin_amdgcn_readfirstlane(tid >> 6), lane = tid & 63, wr = wid >> 2, wc = wid & 3, fr = lane & 15, fq = lane >> 4;
    int K = g.K; asm volatile("" : "+s"(K)); const int nt = K / BK;
    unsigned voffA[2], voffB[2];
#pragma unroll
    for (int i = 0; i < 2; ++i) { int R, C; stage_rc(tid * 16 + i * 8192, R, C); const int Rb = Epi::PERM ? ((R & ~31) + perm32(R & 31)) : R;
        voffA[i] = (unsigned)(R * K + C) * 2u; voffB[i] = (unsigned)(Rb * K + C) * 2u; }
    const size_t kstep = (size_t)(BK * 2);
    const size_t hstep = (size_t)HALF * K * 2;
    const size_t tstep = 2 * hstep;
    const unsigned ldsw = (unsigned)wid * 1024u;
    const int aoff = lds_byte(wr * 64 + fr, fq * 8), boff = lds_byte(wc * 32 + fr, fq * 8);
#define PG8_SA(b, h) (((b) * 2 + (h)) * HTB)
#define PG8_SB(b, h) ((4 + (b) * 2 + (h)) * HTB)
#define PG8_STAGE(bufoff, gbase, voff) do { _Pragma("unroll") for (int _i = 0; _i < 2; ++_i) \
        __builtin_amdgcn_global_load_lds((const unsigned*)((const char*)(gbase) + (voff)[_i]), (PG8_LAS unsigned*)(lds + (bufoff) + ldsw + _i * 8192), 16, 0, 0); } while (0)
#define PG8_CAT(p_) __builtin_shufflevector(*(const PG8_LAS bf16x8*)(p_), *(const PG8_LAS bf16x8*)((p_) + 1024), 0, 1, 2, 3, 4, 5, 6, 7, 8, 9, 10, 11, 12, 13, 14, 15)
#define PG8_LDA(dst, b, h) do { if constexpr (FP8) { _Pragma("unroll") for (int m = 0; m < 4; ++m) dst##8[m] = PG8_CAT(lds + PG8_SA(b, h) + aoff + m * 2048); } \
        else { _Pragma("unroll") for (int m = 0; m < 4; ++m) _Pragma("unroll") for (int k = 0; k < 2; ++k) dst[m][k] = *(const PG8_LAS bf16x8*)(lds + PG8_SA(b, h) + aoff + m * 2048 + k * 1024); } } while (0)
#define PG8_LDB(dst, b, h) do { if constexpr (FP8) { _Pragma("unroll") for (int n = 0; n < 2; ++n) dst##8[n] = PG8_CAT(lds + PG8_SB(b, h) + boff + n * 2048); } \
        else { _Pragma("unroll") for (int n = 0; n < 2; ++n) _Pragma("unroll") for (int k = 0; k < 2; ++k) dst[n][k] = *(const PG8_LAS bf16x8*)(lds + PG8_SB(b, h) + boff + n * 2048 + k * 1024); } } while (0)
#define PG8_MMA(ai, bj, At, Bt) do { __builtin_amdgcn_s_setprio(1); _Pragma("unroll") for (int m = 0; m < 4; ++m) _Pragma("unroll") for (int n = 0; n < 2; ++n) { \
        if constexpr (FP8) asm("v_mfma_scale_f32_16x16x128_f8f6f4 %0, %1, %2, %0, %3, %4 op_sel_hi:[0,0,0]" : "+v"(acc[ai][bj][m][n]) : "v"(Bt##8[n]), "v"(At##8[m]), "v"(sc_w), "v"(sc_x));     \
        else acc[ai][bj][m][n] = mma_tile<false>(Bt[n][0], Bt[n][1], At[m][0], At[m][1], acc[ai][bj][m][n]); } __builtin_amdgcn_s_setprio(0); } while (0)
#define PG8_WAIT_V(n) asm volatile("s_waitcnt vmcnt(" #n ")" ::: "memory")
#define PG8_WAIT_L(n) asm volatile("s_waitcnt lgkmcnt(" #n ")" ::: "memory")
#define PG8_BAR __builtin_amdgcn_s_barrier()
#define PG8_SCHED __builtin_amdgcn_sched_barrier(0)
    Unit cur, nxt; int ui = 0;
    if (!S.next(0, cur)) return;
    f32x4 acc[2][2][4][2];
#pragma unroll
    for (int a = 0; a < 2; ++a)
#pragma unroll
        for (int b = 0; b < 2; ++b)
#pragma unroll
            for (int m = 0; m < 4; ++m)
#pragma unroll
                for (int n = 0; n < 2; ++n) acc[a][b][m][n] = (f32x4){0.f, 0.f, 0.f, 0.f};
    bf16x8 At[4][2], B0[2][2], B1[2][2];
    const int sc_w = SCB * 0x01010101, sc_x = SCA * 0x01010101;
    pg8_bf16x16 At8[4], B08[2], B18[2];
    const char* cA = (const char*)g.A + (size_t)cur.pm * tstep + (size_t)cur.z * g.zA; const char* cB = (const char*)g.Bt + (size_t)cur.pn * tstep + (size_t)cur.z * g.zB;
    S.a_ready(cur);
    if constexpr (SP2) {
        PG8_STAGE(PG8_SB(0, 0), cB, voffB); PG8_STAGE(PG8_SB(0, 1), cB + hstep, voffB); PG8_STAGE(PG8_SA(0, 0), cA, voffA); PG8_STAGE(PG8_SA(0, 1), cA + hstep, voffA);
        if (wr == 1) PG8_BAR;
        PG8_WAIT_V(2); PG8_BAR;
        PG8_STAGE(PG8_SB(1, 0), cB + kstep, voffB); PG8_STAGE(PG8_SA(1, 0), cA + kstep, voffA); PG8_STAGE(PG8_SB(1, 1), cB + hstep + kstep, voffB);
        PG8_WAIT_V(6); PG8_BAR;
    } else {
        PG8_STAGE(PG8_SB(0, 0), cB, voffB); PG8_STAGE(PG8_SA(0, 0), cA, voffA); PG8_STAGE(PG8_SB(0, 1), cB + hstep, voffB); PG8_STAGE(PG8_SA(0, 1), cA + hstep, voffA);
        if (wr == 1) PG8_BAR;
        PG8_WAIT_V(4); PG8_BAR;
        PG8_STAGE(PG8_SB(1, 0), cB + kstep, voffB); PG8_STAGE(PG8_SA(1, 0), cA + kstep, voffA); PG8_STAGE(PG8_SB(1, 1), cB + hstep + kstep, voffB);
        PG8_WAIT_V(6); PG8_BAR;
    }
    for (;;) {
        const bool has_next = S.next(ui + 1, nxt);
        const char* nA = has_next ? (const char*)g.A + (size_t)nxt.pm * tstep + (size_t)nxt.z * g.zA : cA; const char* nB = has_next ? (const char*)g.Bt + (size_t)nxt.pn * tstep + (size_t)nxt.z * g.zB : cB;
        for (int t = 0; t < nt; t += 2) {
            if constexpr (Epi::HOOK) { if (t == Epi::HOOK_T0 || t == Epi::HOOK_T1) E.hook(acc, cur, t, wr, wc, fr, fq); }
            const bool last = (t == nt - 2);
            const char* a1 = cA + (size_t)(t + 1) * kstep;
            const char* a2 = last ? nA : cA + (size_t)(t + 2) * kstep; const char* b2 = last ? nB : cB + (size_t)(t + 2) * kstep;
            const char* a3 = a2 + kstep; const char* b3 = b2 + kstep;
            if (last && has_next) S.a_ready(nxt);
            if constexpr (SP2) {
            PG8_LDB(B0, 0, 0); PG8_LDB(B1, 0, 1); PG8_SCHED; PG8_LDA(At, 0, 0); PG8_STAGE(PG8_SA(1, 1), a1 + hstep, voffA);
            PG8_WAIT_V(8); PG8_WAIT_L(0); PG8_BAR; PG8_MMA(0, 0, At, B0); PG8_MMA(0, 1, At, B1); PG8_BAR; PG8_SCHED;
            PG8_LDA(At, 0, 1); PG8_STAGE(PG8_SB(0, 0), b2, voffB); PG8_STAGE(PG8_SB(0, 1), b2 + hstep, voffB); PG8_STAGE(PG8_SA(0, 0), a2, voffA);
            PG8_WAIT_V(8); PG8_WAIT_L(0); PG8_BAR; PG8_MMA(1, 0, At, B0); PG8_MMA(1, 1, At, B1); PG8_BAR; PG8_SCHED;
            PG8_LDB(B0, 1, 0); PG8_LDB(B1, 1, 1); PG8_SCHED; PG8_LDA(At, 1, 0); PG8_STAGE(PG8_SA(0, 1), a2 + hstep, voffA);
            PG8_WAIT_V(8); PG8_WAIT_L(0); PG8_BAR; PG8_MMA(0, 0, At, B0); PG8_MMA(0, 1, At, B1); PG8_BAR; PG8_SCHED;
            PG8_LDA(At, 1, 1); PG8_STAGE(PG8_SB(1, 0), b3, voffB); PG8_STAGE(PG8_SB(1, 1), b3 + hstep, voffB); PG8_STAGE(PG8_SA(1, 0), a3, voffA);
            PG8_WAIT_V(8); PG8_WAIT_L(0); PG8_BAR; PG8_MMA(1, 0, At, B0); PG8_MMA(1, 1, At, B1); PG8_BAR; PG8_SCHED;
            } else {
            PG8_LDB(B0, 0, 0); PG8_SCHED; PG8_LDA(At, 0, 0); PG8_STAGE(PG8_SA(1, 1), a1 + hstep, voffA);
            PG8_WAIT_L(8); PG8_BAR; PG8_WAIT_L(0); PG8_MMA(0, 0, At, B0); PG8_BAR; PG8_SCHED;
            PG8_LDB(B1, 0, 1); PG8_STAGE(PG8_SB(0, 0), b2, voffB);
            PG8_BAR; PG8_WAIT_L(0); PG8_MMA(0, 1, At, B1); PG8_BAR;
            PG8_LDA(At, 0, 1); PG8_STAGE(PG8_SA(0, 0), a2, voffA);
            PG8_BAR; PG8_WAIT_L(0); PG8_MMA(1, 0, At, B0); PG8_BAR; PG8_SCHED;
            PG8_STAGE(PG8_SB(0, 1), b2 + hstep, voffB);
            PG8_WAIT_V(6); PG8_BAR; PG8_MMA(1, 1, At, B1); PG8_BAR;
            PG8_LDB(B0, 1, 0); PG8_SCHED; PG8_LDA(At, 1, 0); PG8_STAGE(PG8_SA(0, 1), a2 + hstep, voffA);
            PG8_WAIT_L(8); PG8_BAR; PG8_WAIT_L(0); PG8_MMA(0, 0, At, B0); PG8_BAR; PG8_SCHED;
            PG8_LDB(B1, 1, 1); PG8_STAGE(PG8_SB(1, 0), b3, voffB);
            PG8_BAR; PG8_WAIT_L(0); PG8_MMA(0, 1, At, B1); PG8_BAR;
            PG8_LDA(At, 1, 1); PG8_STAGE(PG8_SA(1, 0), a3, voffA);
            PG8_BAR; PG8_WAIT_L(0); PG8_MMA(1, 0, At, B0); PG8_BAR; PG8_SCHED;
            PG8_STAGE(PG8_SB(1, 1), b3 + hstep, voffB);
            PG8_WAIT_V(6); PG8_BAR; PG8_MMA(1, 1, At, B1); PG8_BAR;
            }
        }
        if constexpr (ALIGN_EPI) { if (wr == 0) PG8_BAR; }
        if constexpr (!Epi::AFTER_DRAIN) { E(acc, cur, wr, wc, fr, fq); S.done(cur); }
        if (!has_next) break;
#pragma unroll
        for (int a = 0; a < 2; ++a)
#pragma unroll
            for (int b = 0; b < 2; ++b)
#pragma unroll
                for (int m = 0; m < 4; ++m)
#pragma unroll
                    for (int n = 0; n < 2; ++n) acc[a][b][m][n] = (f32x4){0.f, 0.f, 0.f, 0.f};
        cur = nxt; cA = nA; cB = nB; ++ui;
        if constexpr (ALIGN_EPI) { if (wr == 1) PG8_BAR; }
    }
    PG8_WAIT_V(0);
    if constexpr (!ALIGN_EPI) { if (wr == 0) PG8_BAR; }
    PG8_BAR;
    if constexpr (Epi::AFTER_DRAIN) { E.fused(acc, cur, wr, wc, fr, fq, lds, wid, lane); S.done(cur); }
#undef PG8_SA
#undef PG8_SB
#undef PG8_STAGE
#undef PG8_LDA
#undef PG8_LDB
#undef PG8_MMA
#undef PG8_WAIT_V
#undef PG8_WAIT_L
#undef PG8_BAR
#undef PG8_SCHED
}
}

#define GAS __attribute__((address_space(1)))
#define LAS __attribute__((address_space(3)))
typedef unsigned short bf16;
typedef short bf16x8 __attribute__((ext_vector_type(8)));
typedef float f32x4 __attribute__((ext_vector_type(4)));
typedef float f32x2 __attribute__((ext_vector_type(2)));
typedef float f32x16 __attribute__((ext_vector_type(16)));
typedef unsigned u32x4 __attribute__((ext_vector_type(4)));
typedef unsigned u32x2 __attribute__((ext_vector_type(2)));
typedef __bf16 bf16x2_t __attribute__((ext_vector_type(2)));
typedef GAS unsigned gu32;

#ifndef MK_MULTI
#define MK_MULTI 0
#endif

constexpr int NWAVES = 8, NTHR = 512;
constexpr int BATCH = 2, SEQ = 8192, DM = 2048, M = BATCH * SEQ, DEPTH = 2;
constexpr int IN_TOTAL = 14344, COL_FC = 8192, COL_GATE = 8200;
constexpr int NIN = 12288;
constexpr int NEXP = 16384;
constexpr float LN_EPS = 1e-5f;
constexpr float ALPHA = 1.4142135623730951f;
constexpr float LOG2E = 1.4426950408889634f;
constexpr float SCALE_A = 0.125f * LOG2E;
constexpr float SCALE_C = 0.08838834764831845f * LOG2E;
constexpr int LRU_TC = 64, LRU_NCH = SEQ / LRU_TC;

constexpr size_t MiB = 1u << 20;
constexpr size_t WS_CTL = 0, CTL_ZERO_BYTES = 1 * MiB;
constexpr size_t WS_LOGF = 1 * MiB;
constexpr size_t WS_CUM2 = 1 * MiB + 512 * 1024;
constexpr size_t WS_LSUM = 2 * MiB;
constexpr size_t WS_WLA = 4 * MiB;
constexpr size_t WS_WLX = 4 * MiB + 256 * 1024;
constexpr size_t WS_KEYS = 4 * MiB + 512 * 1024;
constexpr size_t WS_SELI = 8 * MiB;
constexpr size_t WS_SELG = 16 * MiB;
constexpr size_t WS_WPLE = 24 * MiB;
constexpr size_t WS_WIN = 32 * MiB;
constexpr size_t WS_WB8 = 40 * MiB;
constexpr size_t WS_X1B8 = 320 * MiB;
constexpr size_t WS_WG8 = 56 * MiB;
constexpr size_t WS_XB8 = 768 * MiB;
constexpr size_t WS_WV = 80 * MiB;
constexpr size_t WS_WBR = 88 * MiB;
constexpr size_t WS_WO = 100 * MiB;
constexpr size_t WS_WPGQ = 108 * MiB;
constexpr size_t WS_PB = 120 * MiB;
constexpr size_t WS_PU = 128 * MiB;
constexpr size_t WS_PV4 = 144 * MiB;
constexpr size_t WS_PV = 160 * MiB;
constexpr size_t WS_SV4 = 5 * MiB + 131072;
constexpr size_t WS_SU = 5 * MiB, WS_SV = 5 * MiB + 65536;
constexpr size_t WS_XB = 256 * MiB;
constexpr size_t WS_QA = 320 * MiB;
constexpr size_t WS_BG = 352 * MiB;
constexpr size_t WS_QC = 384 * MiB;
constexpr size_t WS_KA = 416 * MiB;
constexpr size_t WS_KC = 448 * MiB;
constexpr size_t WS_VT = 480 * MiB;
constexpr size_t WS_BX = 544 * MiB;
constexpr size_t WS_Y3 = 768 * MiB;
constexpr size_t WS_G = 576 * MiB;
constexpr size_t WS_PW = 576 * MiB;
constexpr size_t WS_PQ = 640 * MiB;
constexpr size_t WS_YB = 768 * MiB;
constexpr size_t WS_AU = 896 * MiB;
constexpr size_t WS_X1B = 896 * MiB;
constexpr size_t WS_END = 960 * MiB;

constexpr int CW_TMO = 0;
constexpr int CW_BAR = 4096;
constexpr int CW_KMAX = 12288;
constexpr int CW_QUEUE = 16384;

constexpr int LDS_BYTES = 147456;
constexpr int MISC_OFF = 131072 + 320;

#define RLX_AGENT __ATOMIC_RELAXED, __HIP_MEMORY_SCOPE_AGENT
#define LDS_WAIT() asm volatile("s_waitcnt lgkmcnt(0)" ::: "memory")
#define VM_WAIT() asm volatile("s_waitcnt vmcnt(0)" ::: "memory")
__device__ __forceinline__ unsigned f2bf(float f) { unsigned u = __builtin_bit_cast(unsigned, f); return (u + 0x7fffu + ((u >> 16) & 1u)) >> 16; }
__device__ __forceinline__ unsigned pk2(float lo, float hi) { return f2bf(lo) | (f2bf(hi) << 16); }
__device__ __forceinline__ unsigned cvtpk(float lo, float hi) { return pg8::cvt_pk_bf16(lo, hi); }
__device__ __forceinline__ float bflo(unsigned w) { return __builtin_bit_cast(float, w << 16); }
__device__ __forceinline__ float bfhi(unsigned w) { return __builtin_bit_cast(float, w & 0xffff0000u); }
__device__ __forceinline__ float fexp(float x) { return __builtin_amdgcn_exp2f(x * LOG2E); }
__device__ __forceinline__ float frcp(float x) { return __builtin_amdgcn_rcpf(x); }
__device__ __forceinline__ float frsq(float x) { return __builtin_amdgcn_rsqf(x); }
__device__ __forceinline__ float flog_sigmoid(float x) { return fminf(x, 0.f) - 0.6931471805599453f * __builtin_amdgcn_logf(1.f + __builtin_amdgcn_exp2f(-LOG2E * fabsf(x))); }
__device__ __forceinline__ float fast_sigmoid(float x) { return __builtin_amdgcn_rcpf(1.f + __builtin_amdgcn_exp2f(-x * LOG2E)); }
__device__ __forceinline__ float wave_sum(float v) {
#pragma unroll
    for (int o = 1; o < 64; o <<= 1) v += __shfl_xor(v, o);
    return v;
}
__device__ __forceinline__ float wave_transpose_reduce64(float (&v)[64], int lane) {
#pragma unroll
    for (int s = 32; s >= 1; s >>= 1) {
        const bool up = (lane & s) != 0;
#pragma unroll
        for (int k = 0; k < s; ++k) { const float a = v[k], b = v[k + s]; const float keep = up ? b : a, send = up ? a : b; v[k] = keep + __shfl_xor(send, s); }
    }
    return v[0];
}

#define XB_TMO      128
#define XB_XCNT(j)  (256  + 64 * (j))
#define XB_XSUB(j)  (1280 + 64 * (j))
#define XB_XGEN(j)  (2304 + 64 * (j))
#define XB_TOP      3328
#define XB_TOPGEN   3392
#define XCD_BAR_WORDS 3456
#define XB_SPIN_CAP (1u << 18)

__device__ __forceinline__ unsigned xb_ld(unsigned* p)              { return __hip_atomic_load(p, __ATOMIC_RELAXED, __HIP_MEMORY_SCOPE_AGENT); }
__device__ __forceinline__ unsigned xb_add(unsigned* p, unsigned v) { return __hip_atomic_fetch_add(p, v, __ATOMIC_RELAXED, __HIP_MEMORY_SCOPE_AGENT); }
__device__ __forceinline__ unsigned xb_xcc_id() { return (unsigned)__builtin_amdgcn_s_getreg((3 << 11) | 20) & 0xFu; }
#define XB_SPIN(cond, bar) do { unsigned _sp = 0; while (cond) { __builtin_amdgcn_s_sleep(1); \
    if ((++_sp & 255u) == 0u) { if (xb_ld(&(bar)[XB_TMO])) break; if (_sp > XB_SPIN_CAP) { atomicAdd(&(bar)[XB_TMO], 1u); break; } } } } while (0)

struct XcdBarrier {
    unsigned* bar; unsigned x;
    volatile LAS unsigned* st;
};

__device__ __forceinline__ XcdBarrier xcd_barrier_post(unsigned* bar, volatile LAS unsigned* st) {
    XcdBarrier b; b.bar = bar; b.x = xb_xcc_id(); b.st = st;
    if (threadIdx.x == 0) (void)xb_add(&bar[XB_XCNT(b.x)], 1u);
    return b;
}
__device__ __forceinline__ void xcd_barrier_complete(unsigned* bar, unsigned x, unsigned& nloc, unsigned& nx) {
    asm volatile("" : "+s"(x));
    const unsigned G = gridDim.x * gridDim.y * gridDim.z;
    unsigned sum, cnt, mine, sp = 0u;
    for (;;) {
        sum = 0u; cnt = 0u; mine = 0u;
#pragma unroll
        for (unsigned j = 0; j < 16; ++j) { const unsigned c = xb_ld(&bar[XB_XCNT(j)]); sum += c; cnt += (c > 0u) ? 1u : 0u; mine = (j == x) ? c : mine; }
        if (sum == G) break;
        __builtin_amdgcn_s_sleep(1);
        if ((++sp & 255u) == 0u) { if (xb_ld(&bar[XB_TMO])) break; if (sp > XB_SPIN_CAP) { atomicAdd(&bar[XB_TMO], 1u); break; } }
    }
    nloc = mine > 0u ? mine : 1u; nx = cnt > 0u ? cnt : 1u;
}

__device__ __forceinline__ void xcd_barrier(const XcdBarrier& b) {
    asm volatile("s_waitcnt vmcnt(0)" ::: "memory");
    __syncthreads();
    if (threadIdx.x == 0) {
        unsigned long long bari_ = (unsigned long long)b.bar; asm volatile("" : "+s"(bari_));
        unsigned* bar = (unsigned*)(GAS unsigned*)bari_;
        __builtin_amdgcn_s_waitcnt(0);
        unsigned nloc = b.st[0], nx = b.st[1];
        if (nloc == 0u) { xcd_barrier_complete(bar, b.x, nloc, nx); b.st[0] = nloc; b.st[1] = nx; }
        const unsigned old = xb_add(&bar[XB_XSUB(b.x)], 1u);
        const unsigned gen = old / nloc;
        if (old + 1u == (gen + 1u) * nloc) {
            __builtin_amdgcn_fence(__ATOMIC_RELEASE, "agent");
            asm volatile("s_waitcnt vmcnt(0)" ::: "memory");
            const unsigned og = xb_add(&bar[XB_TOP], 1u);
            const unsigned tg = og / nx;
            if (og + 1u == (tg + 1u) * nx) xb_add(&bar[XB_TOPGEN], 1u);
            else XB_SPIN(xb_ld(&bar[XB_TOPGEN]) == tg, bar);
            __builtin_amdgcn_fence(__ATOMIC_ACQUIRE, "agent");
            xb_add(&bar[XB_XGEN(b.x)], 1u);
            asm volatile("s_waitcnt vmcnt(0)" ::: "memory");
        } else {
            XB_SPIN(xb_ld(&bar[XB_XGEN(b.x)]) == gen, bar);
            __builtin_amdgcn_fence(__ATOMIC_ACQUIRE, "agent");
            asm volatile("s_waitcnt vmcnt(0)" ::: "memory");
        }
    }
    __syncthreads();
}


using pg8::Unit;
#define EPI_LOOP_BEGIN  _Pragma("unroll") for (int ai = 0; ai < 2; ++ai) _Pragma("unroll") for (int m = 0; m < 4; ++m) { const int row = row0 + ai * 128 + m * 16; _Pragma("unroll") for (int bj = 0; bj < 2; ++bj) { f32x4 v0 = acc[ai][bj][m][0], v1 = acc[ai][bj][m][1]; const int cj = bj * 128;
#define EPI_LOOP_END } }
#define EPI_HALF_BEGIN(ai_) { constexpr int ai = (ai_); _Pragma("unroll") for (int m = 0; m < 4; ++m) { const int row = row0 + ai * 128 + m * 16; _Pragma("unroll") for (int bj = 0; bj < 2; ++bj) { f32x4 v0 = acc[ai][bj][m][0], v1 = acc[ai][bj][m][1]; const int cj = bj * 128;
#define EPI_HALF_END } } }
__device__ __forceinline__ unsigned pack4_fp8(float a, float b, float c, float d, float s) {
    int p = __builtin_amdgcn_cvt_pk_fp8_f32(__builtin_amdgcn_fmed3f(a * s, -448.f, 448.f), __builtin_amdgcn_fmed3f(b * s, -448.f, 448.f), 0, false);
    return (unsigned)__builtin_amdgcn_cvt_pk_fp8_f32(__builtin_amdgcn_fmed3f(c * s, -448.f, 448.f), __builtin_amdgcn_fmed3f(d * s, -448.f, 448.f), p, true);
}
__device__ __forceinline__ u32x2 pack8_fp8(f32x4 v0, f32x4 v1, float s) {
#define F8C(x_) __builtin_amdgcn_fmed3f((x_) * s, -448.f, 448.f)
    int p0 = __builtin_amdgcn_cvt_pk_fp8_f32(F8C(v0[0]), F8C(v0[1]), 0, false); p0 = __builtin_amdgcn_cvt_pk_fp8_f32(F8C(v0[2]), F8C(v0[3]), p0, true);
    int p1 = __builtin_amdgcn_cvt_pk_fp8_f32(F8C(v1[0]), F8C(v1[1]), 0, false); p1 = __builtin_amdgcn_cvt_pk_fp8_f32(F8C(v1[2]), F8C(v1[3]), p1, true);
#undef F8C
    u32x2 o; o.x = (unsigned)p0; o.y = (unsigned)p1; return o;
}
__device__ __forceinline__ u32x4 pack8(f32x4 v0, f32x4 v1) { u32x4 w; w.x = cvtpk(v0[0], v0[1]); w.y = cvtpk(v0[2], v0[3]); w.z = cvtpk(v1[0], v1[1]); w.w = cvtpk(v1[2], v1[3]); return w; }

__device__ __forceinline__ bf16* gate_tile_ptr(bf16* G, int pm, int gz, int wave, int lane) { return G + ((((size_t)(pm * 24 + gz) * 8 + wave) * 16) * 64 + lane) * 8; }
struct EpiInProj {
    static constexpr bool PERM = true, AFTER_DRAIN = false, HOOK = false; static constexpr int HOOK_T0 = -1, HOOK_T1 = -1;
    unsigned char* ws; const float* b_in; int pn_off, jump_at = 1 << 30, jump = 0;
    __device__ __forceinline__ void operator()(const f32x4 (&acc)[2][2][4][2], const Unit& u, int wr, int wc, int fr, int fq) const {
        asm volatile("" : "+v"(fr));
        const int row0 = u.pm * 256 + wr * 64 + fr, colt = (u.pn + pn_off + (u.pn >= jump_at ? jump : 0)) * 256;
        bf16* base; int ldc, c0, bcol; float sc = 1.f;
        if (colt < 6144) { const int t = colt >> 10; c0 = colt & 1023; ldc = 1024;
            const size_t off = t == 0 ? WS_QA : t == 1 ? WS_KA : t == 2 ? WS_BX : t == 3 ? WS_BG : t == 4 ? WS_QC : WS_KC;
            base = (bf16*)(ws + off); sc = t == 0 ? SCALE_A : (t == 4 ? SCALE_C : 1.f);
            bcol = colt < 2048 ? colt : colt + 1024; }
        else { base = (bf16*)(ws + WS_G); ldc = 6144; c0 = colt - 6144; bcol = colt - 6144 + COL_GATE; }
        const bool gate = colt >= 6144;
        bf16* gt = gate_tile_ptr((bf16*)(ws + WS_G), u.pm, (colt - 6144) >> 8, wr * 4 + wc, fq * 16 + (fr & 15));
        const int col0 = c0 + wc * 32 + 8 * fq; const float* bp = b_in + bcol + wc * 32 + 8 * fq;
        f32x4 bv[2][2];
#pragma unroll
        for (int bj = 0; bj < 2; ++bj)
#pragma unroll
            for (int n = 0; n < 2; ++n) bv[bj][n] = *(const f32x4*)(bp + bj * 128 + 4 * n);
        EPI_LOOP_BEGIN
            v0 = (v0 + bv[bj][0]) * sc; v1 = (v1 + bv[bj][1]) * sc;
            if (gate) {
#pragma unroll
                for (int i = 0; i < 4; ++i) { v0[i] = __builtin_amdgcn_exp2f(-LOG2E * fminf(fmaxf(v0[i], -30.f), 30.f)); v1[i] = __builtin_amdgcn_exp2f(-LOG2E * fminf(fmaxf(v1[i], -30.f), 30.f)); }
                *(u32x4*)(gt + ((ai * 4 + m) * 2 + bj) * 512) = pack8(v0, v1); }
            else *(u32x4*)(base + (size_t)row * ldc + col0 + cj) = pack8(v0, v1);
        EPI_LOOP_END
    }
};
struct EpiVT {
    static constexpr bool PERM = true, AFTER_DRAIN = false, HOOK = false; static constexpr int HOOK_T0 = -1, HOOK_T1 = -1;
    bf16* VT; const float* b_in;
    __device__ __forceinline__ void operator()(const f32x4 (&acc)[2][2][4][2], const Unit& u, int wr, int wc, int fr, int fq) const {
        asm volatile("" : "+v"(fr));
        const int row0 = u.pm * 256 + wr * 64 + fr, col0 = u.pn * 256 + wc * 32 + 8 * fq;
        const float* bp = b_in + (u.pm < 4 ? 2048 : 7168 - 1024);
        EPI_LOOP_BEGIN
            const float br = bp[row];
            v0 = v0 + br; v1 = v1 + br;
            *(u32x4*)(VT + (size_t)row * M + col0 + cj) = pack8(v0, v1);
        EPI_LOOP_END
    }
};
struct EpiMerge {
    static constexpr bool PERM = true, AFTER_DRAIN = false, HOOK = true; static constexpr int HOOK_T0 = 8, HOOK_T1 = 16;
    const bf16* G; bf16* O;
    static __device__ __forceinline__ float e2(float g) { return __builtin_amdgcn_exp2f(-LOG2E * fminf(fmaxf(g, -30.f), 30.f)); }
    __device__ __forceinline__ void hook(f32x4 (&acc)[2][2][4][2], const Unit& u, int t, int wr, int wc, int fr, int fq) const {
        asm volatile("" : "+v"(fr));
        const int z = t == HOOK_T0 ? 0 : 1, ln = fq * 16 + (fr & 15);
        const bf16* ga_ = gate_tile_ptr((bf16*)G, u.pm, z * 8 + u.pn, wr * 4 + wc, ln); const bf16* gb_ = gate_tile_ptr((bf16*)G, u.pm, (z + 1) * 8 + u.pn, wr * 4 + wc, ln);
#pragma unroll
        for (int ai = 0; ai < 2; ++ai) {
            u32x4 pa[8], pb[8];
#pragma unroll
            for (int q = 0; q < 8; ++q) { pa[q] = *(const u32x4*)(ga_ + (ai * 8 + q) * 512); pb[q] = *(const u32x4*)(gb_ + (ai * 8 + q) * 512); }
            __builtin_amdgcn_sched_barrier(0);
#pragma unroll
            for (int m = 0; m < 4; ++m)
#pragma unroll
                for (int bj = 0; bj < 2; ++bj) { const u32x4 ga = pa[m * 2 + bj], gb = pb[m * 2 + bj];
                    const float a[8] = {bflo(ga.x), bfhi(ga.x), bflo(ga.y), bfhi(ga.y), bflo(ga.z), bfhi(ga.z), bflo(ga.w), bfhi(ga.w)};
                    const float b[8] = {bflo(gb.x), bfhi(gb.x), bflo(gb.y), bfhi(gb.y), bflo(gb.z), bfhi(gb.z), bflo(gb.w), bfhi(gb.w)};
#pragma unroll
                    for (int i = 0; i < 4; ++i) { acc[ai][bj][m][0][i] *= (1.f + b[i]) * __builtin_amdgcn_rcpf(1.f + a[i]); acc[ai][bj][m][1][i] *= (1.f + b[4 + i]) * __builtin_amdgcn_rcpf(1.f + a[4 + i]); } }
        }
    }
    __device__ __forceinline__ void operator()(const f32x4 (&acc)[2][2][4][2], const Unit& u, int wr, int wc, int fr, int fq) const {
        asm volatile("" : "+v"(fr));
        const int row0 = u.pm * 256 + wr * 64 + fr, col0 = u.pn * 256 + wc * 32 + 8 * fq;
        const bf16* g2_ = gate_tile_ptr((bf16*)G, u.pm, 16 + u.pn, wr * 4 + wc, fq * 16 + (fr & 15));
        { u32x4 pre[8];
#pragma unroll
          for (int q = 0; q < 8; ++q) pre[q] = *(const u32x4*)(g2_ + (0 * 8 + q) * 512);
          __builtin_amdgcn_sched_barrier(0);
          EPI_HALF_BEGIN(0)
            const u32x4 gw = pre[m * 2 + bj];
            const float g[8] = {bflo(gw.x), bfhi(gw.x), bflo(gw.y), bfhi(gw.y), bflo(gw.z), bfhi(gw.z), bflo(gw.w), bfhi(gw.w)};
#pragma unroll
            for (int i = 0; i < 4; ++i) { v0[i] *= __builtin_amdgcn_rcpf(1.f + g[i]); v1[i] *= __builtin_amdgcn_rcpf(1.f + g[4 + i]); }
            *(u32x2*)((unsigned char*)O + (size_t)row * 2048 + col0 + cj) = pack8_fp8(v0, v1, 8.f);
          EPI_HALF_END }
        { u32x4 pre[8];
#pragma unroll
          for (int q = 0; q < 8; ++q) pre[q] = *(const u32x4*)(g2_ + (1 * 8 + q) * 512);
          __builtin_amdgcn_sched_barrier(0);
          EPI_HALF_BEGIN(1)
            const u32x4 gw = pre[m * 2 + bj];
            const float g[8] = {bflo(gw.x), bfhi(gw.x), bflo(gw.y), bfhi(gw.y), bflo(gw.z), bfhi(gw.z), bflo(gw.w), bfhi(gw.w)};
#pragma unroll
            for (int i = 0; i < 4; ++i) { v0[i] *= __builtin_amdgcn_rcpf(1.f + g[i]); v1[i] *= __builtin_amdgcn_rcpf(1.f + g[4 + i]); }
            *(u32x2*)((unsigned char*)O + (size_t)row * 2048 + col0 + cj) = pack8_fp8(v0, v1, 8.f);
          EPI_HALF_END }
    }
};
struct EpiWo {
    static constexpr bool PERM = true, AFTER_DRAIN = false, HOOK = false; static constexpr int HOOK_T0 = -1, HOOK_T1 = -1;
    const bf16* xres; bf16* Y;
    __device__ __forceinline__ void operator()(const f32x4 (&acc)[2][2][4][2], const Unit& u, int wr, int wc, int fr, int fq) const {
        asm volatile("" : "+v"(fr));
        const int row0 = u.pm * 256 + wr * 64 + fr, col0 = u.pn * 256 + wc * 32 + 8 * fq;
        { u32x4 pre[8];
#pragma unroll
          for (int q = 0; q < 8; ++q) pre[q] = *(const u32x4*)(xres + (size_t)(row0 + 0 * 128 + (q >> 1) * 16) * 2048 + col0 + (q & 1) * 128);
          __builtin_amdgcn_sched_barrier(0);
          EPI_HALF_BEGIN(0)
            const u32x4 xr = pre[m * 2 + bj];
            const size_t o = (size_t)row * 2048 + col0 + cj;
            v0 += ALPHA * (f32x4){bflo(xr.x), bfhi(xr.x), bflo(xr.y), bfhi(xr.y)}; v1 += ALPHA * (f32x4){bflo(xr.z), bfhi(xr.z), bflo(xr.w), bfhi(xr.w)};
            *(u32x4*)(Y + o) = pack8(v0, v1);
          EPI_HALF_END }
        { u32x4 pre[8];
#pragma unroll
          for (int q = 0; q < 8; ++q) pre[q] = *(const u32x4*)(xres + (size_t)(row0 + 1 * 128 + (q >> 1) * 16) * 2048 + col0 + (q & 1) * 128);
          __builtin_amdgcn_sched_barrier(0);
          EPI_HALF_BEGIN(1)
            const u32x4 xr = pre[m * 2 + bj];
            const size_t o = (size_t)row * 2048 + col0 + cj;
            v0 += ALPHA * (f32x4){bflo(xr.x), bfhi(xr.x), bflo(xr.y), bfhi(xr.y)}; v1 += ALPHA * (f32x4){bflo(xr.z), bfhi(xr.z), bflo(xr.w), bfhi(xr.w)};
            *(u32x4*)(Y + o) = pack8(v0, v1);
          EPI_HALF_END }
    }
};
struct EpiPlain {
    static constexpr bool PERM = true, AFTER_DRAIN = false, HOOK = false; static constexpr int HOOK_T0 = -1, HOOK_T1 = -1;
    bf16* O; int ldc;
    __device__ __forceinline__ void operator()(const f32x4 (&acc)[2][2][4][2], const Unit& u, int wr, int wc, int fr, int fq) const {
        asm volatile("" : "+v"(fr));
        const int row0 = u.pm * 256 + wr * 64 + fr, col0 = u.pn * 256 + wc * 32 + 8 * fq;
        EPI_LOOP_BEGIN
            *(u32x4*)(O + (size_t)row * ldc + col0 + cj) = pack8(v0, v1);
        EPI_LOOP_END
    }
};
struct EpiPgq {
    static constexpr bool PERM = true, AFTER_DRAIN = false, HOOK = false; static constexpr int HOOK_T0 = -1, HOOK_T1 = -1;
    bf16* PW; bf16* PQ; const float* bpg; bf16* PLEo; int pn_off;
    __device__ __forceinline__ void operator()(const f32x4 (&acc)[2][2][4][2], const Unit& u, int wr, int wc, int fr, int fq) const {
        asm volatile("" : "+v"(fr));
        const int row0 = u.pm * 256 + wr * 64 + fr, colt = (u.pn + pn_off) * 256, cw = wc * 32 + 8 * fq;
        if (colt < 2048) {
            const int col0 = colt + cw;
            f32x4 bv[2][2];
#pragma unroll
            for (int bj = 0; bj < 2; ++bj)
#pragma unroll
                for (int n = 0; n < 2; ++n) bv[bj][n] = *(const f32x4*)(bpg + col0 + bj * 128 + 4 * n);
        { u32x4 pre[8];
#pragma unroll
          for (int q = 0; q < 8; ++q) pre[q] = *(const u32x4*)(PW + (size_t)(row0 + 0 * 128 + (q >> 1) * 16) * 2048 + col0 + (q & 1) * 128);
          __builtin_amdgcn_sched_barrier(0);
          EPI_HALF_BEGIN(0)
            const u32x4 pw = pre[m * 2 + bj];
                const size_t po = (size_t)row * 2048 + col0 + cj;
                f32x4 p0 = {bflo(pw.x), bfhi(pw.x), bflo(pw.y), bfhi(pw.y)}, p1 = {bflo(pw.z), bfhi(pw.z), bflo(pw.w), bfhi(pw.w)};
                v0 += bv[bj][0]; v1 += bv[bj][1];
#pragma unroll
                for (int i = 0; i < 4; ++i) { v0[i] = fast_sigmoid(v0[i]) * p0[i]; v1[i] = fast_sigmoid(v1[i]) * p1[i]; }
                *(u32x4*)(PLEo + po) = pack8(v0, v1);
          EPI_HALF_END }
        { u32x4 pre[8];
#pragma unroll
          for (int q = 0; q < 8; ++q) pre[q] = *(const u32x4*)(PW + (size_t)(row0 + 1 * 128 + (q >> 1) * 16) * 2048 + col0 + (q & 1) * 128);
          __builtin_amdgcn_sched_barrier(0);
          EPI_HALF_BEGIN(1)
            const u32x4 pw = pre[m * 2 + bj];
                const size_t po = (size_t)row * 2048 + col0 + cj;
                f32x4 p0 = {bflo(pw.x), bfhi(pw.x), bflo(pw.y), bfhi(pw.y)}, p1 = {bflo(pw.z), bfhi(pw.z), bflo(pw.w), bfhi(pw.w)};
                v0 += bv[bj][0]; v1 += bv[bj][1];
#pragma unroll
                for (int i = 0; i < 4; ++i) { v0[i] = fast_sigmoid(v0[i]) * p0[i]; v1[i] = fast_sigmoid(v1[i]) * p1[i]; }
                *(u32x4*)(PLEo + po) = pack8(v0, v1);
          EPI_HALF_END }
        } else {
            const int col0 = colt - 2048 + cw;
            EPI_LOOP_BEGIN
                *(u32x4*)(PQ + (size_t)row * 1024 + col0 + cj) = pack8(v0, v1);
            EPI_LOOP_END
        }
    }
};
struct MergeOrder {
    pg8::StaticOrder S;
    __device__ __forceinline__ bool next(int i, Unit& u) const { const int t = i / 3; if (!S.next(t, u)) return false; u.z = i - 3 * t; return true; }
    __device__ __forceinline__ void a_ready(const Unit&) const {}
    __device__ __forceinline__ void done(const Unit&) const {}
};

struct Ctx {
    LAS unsigned char* lds; unsigned char* ws; gu32* ctl;
    int tid, lane, wave, G, gw, NGW, bid;
};
__device__ __forceinline__ Ctx fresh_ctx(const Ctx& C) {
    Ctx P = C; int t = C.tid; asm volatile("" : "+v"(t)); unsigned long long wi = (unsigned long long)C.ws; asm volatile("" : "+s"(wi));
    unsigned char* w = (unsigned char*)(GAS unsigned char*)wi;
    int bid = blockIdx.x, G = gridDim.x; asm volatile("" : "+s"(bid), "+s"(G));
    P.tid = t; P.lane = t & 63; P.wave = __builtin_amdgcn_readfirstlane(t >> 6); P.ws = w; P.ctl = (gu32*)(w + WS_CTL); P.bid = bid; P.G = G; P.gw = bid * NWAVES + P.wave; P.NGW = G * NWAVES; return P;
}

template <bool FP8OUT = false>
__device__ __forceinline__ void transpose_item(const float* W, int ldw, int col0, int K, bf16* WT, int rowoff, LAS float* scr, int kb, int nb, int lane, int ldt = 0) {
    if (ldt == 0) ldt = K;
    const int k0 = 64 * kb, n0 = 32 * nb;
    { f32x4 v[8]; const int c4 = 4 * (lane & 7), r8 = lane >> 3;
#pragma unroll
      for (int i = 0; i < 8; ++i) v[i] = *(const f32x4*)(W + (size_t)(k0 + 8 * i + r8) * ldw + col0 + n0 + c4);
#pragma unroll
      for (int i = 0; i < 8; ++i) { LAS float* d = scr + (8 * i + r8) * 33 + c4; d[0] = v[i][0]; d[1] = v[i][1]; d[2] = v[i][2]; d[3] = v[i][3]; } }
    LDS_WAIT(); asm volatile("" ::: "memory");
    const int c = lane & 7;
#pragma unroll
    for (int j = 0; j < 4; ++j) { const int n = (lane >> 3) + 8 * j; const LAS float* s = scr + (8 * c) * 33 + n;
        if constexpr (FP8OUT) { int p0 = __builtin_amdgcn_cvt_pk_fp8_f32(s[0 * 33] * 64.f, s[1 * 33] * 64.f, 0, false); p0 = __builtin_amdgcn_cvt_pk_fp8_f32(s[2 * 33] * 64.f, s[3 * 33] * 64.f, p0, true);
            int p1 = __builtin_amdgcn_cvt_pk_fp8_f32(s[4 * 33] * 64.f, s[5 * 33] * 64.f, 0, false); p1 = __builtin_amdgcn_cvt_pk_fp8_f32(s[6 * 33] * 64.f, s[7 * 33] * 64.f, p1, true);
            u32x2 o; o.x = (unsigned)p0; o.y = (unsigned)p1; *(u32x2*)((unsigned char*)WT + (size_t)(rowoff + n0 + n) * ldt + k0 + 8 * c) = o; }
        else { u32x4 o; o.x = pk2(s[0 * 33], s[1 * 33]); o.y = pk2(s[2 * 33], s[3 * 33]); o.z = pk2(s[4 * 33], s[5 * 33]); o.w = pk2(s[6 * 33], s[7 * 33]);
            *(u32x4*)(WT + (size_t)(rowoff + n0 + n) * ldt + k0 + 8 * c) = o; } }
    LDS_WAIT(); asm volatile("" ::: "memory");
}
__device__ __forceinline__ void cvt_rows(const Ctx& C, const float* __restrict__ src, bf16* __restrict__ dst, size_t n) {
    const size_t nth = (size_t)C.G * NTHR, t0 = (size_t)C.bid * NTHR + C.tid;
    for (size_t i = t0; i < n / 8; i += nth) { const f32x4 a = *(const f32x4*)(src + 8 * i), b = *(const f32x4*)(src + 8 * i + 4);
        u32x4 o; o.x = pk2(a[0], a[1]); o.y = pk2(a[2], a[3]); o.z = pk2(b[0], b[1]); o.w = pk2(b[2], b[3]); *(u32x4*)(dst + 8 * i) = o; }
}
constexpr int P6ROW = 1536;
__device__ __forceinline__ unsigned fp6_code(float v, float inv) {
    const float a = fminf(fabsf(v * inv), 7.5f);
    int e = (int)(__builtin_bit_cast(unsigned, a) >> 23) - 127; e = e < 0 ? 0 : (e > 2 ? 2 : e);
    const unsigned q = (unsigned)__builtin_rintf(__builtin_amdgcn_ldexpf(a, 3 - e));
    return (q + 8u * (unsigned)e) | ((__builtin_bit_cast(unsigned, v) >> 26) & 0x20u);
}
__device__ __forceinline__ void cvt_rows_fp6(const Ctx& C, const float* src, unsigned char* dst, float* scales, int nrows) {
    for (int r = C.gw; r < nrows; r += C.NGW) {
        const float* sp = src + (size_t)r * DM + 16 * C.lane; f32x4 v[2][4]; float am = 0.f;
#pragma unroll
        for (int j = 0; j < 2; ++j)
#pragma unroll
            for (int q = 0; q < 4; ++q) { v[j][q] = *(const f32x4*)(sp + 1024 * j + 4 * q); am = fmaxf(am, fmaxf(fmaxf(fabsf(v[j][q][0]), fabsf(v[j][q][1])), fmaxf(fabsf(v[j][q][2]), fabsf(v[j][q][3])))); }
#pragma unroll
        for (int o = 1; o < 64; o <<= 1) am = fmaxf(am, __shfl_xor(am, o));
        const float sc = am > 0.f ? am * (1.f / 7.5f) : 1.f, inv = frcp(sc);
#pragma unroll
        for (int j = 0; j < 2; ++j) { unsigned c[16];
#pragma unroll
            for (int i = 0; i < 16; ++i) c[i] = fp6_code(v[j][i >> 2][i & 3], inv);
            unsigned* dp = (unsigned*)(dst + (size_t)r * P6ROW + 768 * j) + 3 * C.lane;
            dp[0] = c[0] | (c[1] << 6) | (c[2] << 12) | (c[3] << 18) | (c[4] << 24) | (c[5] << 30);
            dp[1] = (c[5] >> 2) | (c[6] << 4) | (c[7] << 10) | (c[8] << 16) | (c[9] << 22) | (c[10] << 28);
            dp[2] = (c[10] >> 4) | (c[11] << 2) | (c[12] << 8) | (c[13] << 14) | (c[14] << 20) | (c[15] << 26); }
        if (C.lane == 0) scales[r] = sc;
    }
}
constexpr int P4ROW = 1024;
__device__ __forceinline__ unsigned fp4_code(float v, float inv) {
    const float a = fminf(fabsf(v * inv), 6.f);
    int e = (int)(__builtin_bit_cast(unsigned, a) >> 23) - 127; e = e < 0 ? 0 : (e > 2 ? 2 : e);
    const unsigned q = (unsigned)__builtin_rintf(__builtin_amdgcn_ldexpf(a, 1 - e));
    return (q + 2u * (unsigned)e) | ((__builtin_bit_cast(unsigned, v) >> 28) & 0x8u);
}
__device__ __forceinline__ void cvt_rows_fp4(const Ctx& C, const float* src, unsigned char* dst, float* scales, int nrows) {
    for (int r = C.gw; r < nrows; r += C.NGW) {
        const float* sp = src + (size_t)r * DM + 16 * C.lane; f32x4 v[2][4]; float am = 0.f;
#pragma unroll
        for (int j = 0; j < 2; ++j)
#pragma unroll
            for (int q = 0; q < 4; ++q) { v[j][q] = *(const f32x4*)(sp + 1024 * j + 4 * q); am = fmaxf(am, fmaxf(fmaxf(fabsf(v[j][q][0]), fabsf(v[j][q][1])), fmaxf(fabsf(v[j][q][2]), fabsf(v[j][q][3])))); }
#pragma unroll
        for (int o = 1; o < 64; o <<= 1) am = fmaxf(am, __shfl_xor(am, o));
        const float sc = am > 0.f ? am * (0.85f / 6.f) : 1.f, inv = frcp(sc);
        unsigned d[4];
#pragma unroll
        for (int h = 0; h < 4; ++h) { unsigned w = 0u;
#pragma unroll
            for (int i = 0; i < 8; ++i) w |= fp4_code(v[h >> 1][2 * (h & 1) + (i >> 2)][i & 3], inv) << (4 * i);
            d[h] = w; }
        u32x4 o; o.x = d[0]; o.y = d[1]; o.z = d[2]; o.w = d[3];
        *(u32x4*)(dst + (size_t)r * P4ROW + 16 * C.lane) = o;
        if (C.lane == 0) scales[r] = sc;
    }
}
__device__ __forceinline__ void cvt_rows_fp6_fp4(const Ctx& C, const float* src, unsigned char* dst6, float* scales6, unsigned char* dst4, float* scales4, int nrows) {
    for (int r = C.gw; r < nrows; r += C.NGW) {
        const float* sp = src + (size_t)r * DM + 16 * C.lane; f32x4 v[2][4]; float am = 0.f;
#pragma unroll
        for (int j = 0; j < 2; ++j)
#pragma unroll
            for (int q = 0; q < 4; ++q) { v[j][q] = *(const f32x4*)(sp + 1024 * j + 4 * q); am = fmaxf(am, fmaxf(fmaxf(fabsf(v[j][q][0]), fabsf(v[j][q][1])), fmaxf(fabsf(v[j][q][2]), fabsf(v[j][q][3])))); }
#pragma unroll
        for (int o = 1; o < 64; o <<= 1) am = fmaxf(am, __shfl_xor(am, o));
        const float sc6 = am > 0.f ? am * (1.f / 7.5f) : 1.f, inv6 = frcp(sc6), sc4 = am > 0.f ? am * (0.85f / 6.f) : 1.f, inv4 = frcp(sc4);
#pragma unroll
        for (int j = 0; j < 2; ++j) { unsigned c[16];
#pragma unroll
            for (int i = 0; i < 16; ++i) c[i] = fp6_code(v[j][i >> 2][i & 3], inv6);
            unsigned* dp = (unsigned*)(dst6 + (size_t)r * P6ROW + 768 * j) + 3 * C.lane;
            dp[0] = c[0] | (c[1] << 6) | (c[2] << 12) | (c[3] << 18) | (c[4] << 24) | (c[5] << 30);
            dp[1] = (c[5] >> 2) | (c[6] << 4) | (c[7] << 10) | (c[8] << 16) | (c[9] << 22) | (c[10] << 28);
            dp[2] = (c[10] >> 4) | (c[11] << 2) | (c[12] << 8) | (c[13] << 14) | (c[14] << 20) | (c[15] << 26); }
        unsigned d[4];
#pragma unroll
        for (int h = 0; h < 4; ++h) { unsigned w = 0u;
#pragma unroll
            for (int i = 0; i < 8; ++i) w |= fp4_code(v[h >> 1][2 * (h & 1) + (i >> 2)][i & 3], inv4) << (4 * i);
            d[h] = w; }
        u32x4 o; o.x = d[0]; o.y = d[1]; o.z = d[2]; o.w = d[3];
        *(u32x4*)(dst4 + (size_t)r * P4ROW + 16 * C.lane) = o;
        if (C.lane == 0) { scales6[r] = sc6; scales4[r] = sc4; }
    }
}
template <bool F32SRC>
__device__ __forceinline__ void fc_phase(const Ctx& C, const float* __restrict__ xsrc, const bf16* __restrict__ xsrcb, const float* __restrict__ w_in, const float* __restrict__ b_in, bf16* __restrict__ xcopy, unsigned char* __restrict__ x8) {
    LAS float* Wl = (LAS float*)C.lds;
    { float t[32];
#pragma unroll
      for (int q = 0; q < 32; ++q) { const int i = C.tid + q * NTHR; t[q] = w_in[(size_t)(i >> 3) * IN_TOTAL + COL_FC + (i & 7)]; }
#pragma unroll
      for (int q = 0; q < 32; ++q) { const int i = C.tid + q * NTHR; Wl[(i & 7) * 2048 + (i >> 3)] = t[q]; } }
    __syncthreads();
    float* LOGF = (float*)(C.ws + WS_LOGF);
    for (int rb = C.gw; rb < M / 8; rb += C.NGW) {
        const int m0 = rb * 8;
        float acc[64];
#pragma unroll
        for (int i = 0; i < 64; ++i) acc[i] = 0.f;
        f32x4 xa[8]; u32x2 ra[8];
#define FC_LOAD(XV, RV, j_) _Pragma("unroll") for (int r = 0; r < 8; ++r) { if constexpr (F32SRC) XV[r] = *(const f32x4*)(xsrc + (size_t)(m0 + r) * DM + 256 * (j_) + 4 * C.lane); \
            else RV[r] = *(const u32x2*)(xsrcb + (size_t)(m0 + r) * DM + 256 * (j_) + 4 * C.lane); }
#define FC_STEP(XV, RV, j_) { f32x4 wv[8]; _Pragma("unroll") for (int h = 0; h < 8; ++h) wv[h] = *(const LAS f32x4*)(Wl + h * 2048 + 256 * (j_) + 4 * C.lane); \
            _Pragma("unroll") for (int r = 0; r < 8; ++r) { f32x4 xv; if constexpr (F32SRC) { xv = XV[r]; *(u32x2*)(xcopy + (size_t)(m0 + r) * DM + 256 * (j_) + 4 * C.lane) = (u32x2){pk2(xv[0], xv[1]), pk2(xv[2], xv[3])}; } \
                else xv = (f32x4){bflo(RV[r].x), bfhi(RV[r].x), bflo(RV[r].y), bfhi(RV[r].y)}; \
                { int p8_ = __builtin_amdgcn_cvt_pk_fp8_f32(__builtin_amdgcn_fmed3f(xv[0], -448.f, 448.f), __builtin_amdgcn_fmed3f(xv[1], -448.f, 448.f), 0, false); p8_ = __builtin_amdgcn_cvt_pk_fp8_f32(__builtin_amdgcn_fmed3f(xv[2], -448.f, 448.f), __builtin_amdgcn_fmed3f(xv[3], -448.f, 448.f), p8_, true); \
                  *(unsigned*)(x8 + (size_t)(m0 + r) * DM + 256 * (j_) + 4 * C.lane) = (unsigned)p8_; } \
                _Pragma("unroll") for (int h = 0; h < 8; ++h) acc[r * 8 + h] += (xv[0] * wv[h][0] + xv[1] * wv[h][1]) + (xv[2] * wv[h][2] + xv[3] * wv[h][3]); } }
#pragma unroll 1
        for (int j = 0; j < 8; ++j) {
            FC_LOAD(xa, ra, j) __builtin_amdgcn_sched_barrier(0);
            FC_STEP(xa, ra, j) __builtin_amdgcn_sched_barrier(0);
        }
#undef FC_LOAD
#undef FC_STEP
        const float tot = wave_transpose_reduce64(acc, C.lane);
        const int r = C.lane >> 3, h = C.lane & 7, m = m0 + r, b = m / SEQ, s = m % SEQ;
        const float fc = tot + b_in[COL_FC + h];
        const float lf = fminf(fc, 0.f) - 0.6931471805599453f * __builtin_amdgcn_logf(1.f + __builtin_amdgcn_exp2f(-LOG2E * fabsf(fc)));
        LOGF[(size_t)(b * 8 + h) * SEQ + s] = lf;
    }
    __syncthreads();
}
__device__ __forceinline__ void cumsum_seq(const Ctx& C, int seq) {
    const float* src = (const float*)(C.ws + WS_LOGF) + (size_t)seq * SEQ + 128 * C.lane;
    float* dst = (float*)(C.ws + WS_CUM2) + (size_t)seq * SEQ + 128 * C.lane;
    float tot = 0.f;
    for (int i = 0; i < 32; ++i) { const f32x4 v = *(const f32x4*)(src + 4 * i); tot += (v[0] + v[1]) + (v[2] + v[3]); }
    float inc = tot;
#pragma unroll
    for (int o = 1; o < 64; o <<= 1) { const float t = __shfl_up(inc, o); if (C.lane >= o) inc += t; }
    float run = inc - tot;
    for (int i = 0; i < 32; ++i) { const f32x4 v = *(const f32x4*)(src + 4 * i); f32x4 o;
        run += v[0]; o[0] = run * LOG2E; run += v[1]; o[1] = run * LOG2E; run += v[2]; o[2] = run * LOG2E; run += v[3]; o[3] = run * LOG2E;
        *(f32x4*)(dst + 4 * i) = o; }
}
struct InPtrs { const float* in[27]; };
#define CAS __attribute__((address_space(4)))
struct InRef { const float* const CAS* p; __device__ __forceinline__ const float* in(int k) const { return (const float*)(GAS const float*)p[k]; } };
__device__ __forceinline__ InRef fresh_in() { unsigned o = 0; asm volatile("" : "+s"(o)); return InRef{(const float* const CAS*)((const char CAS*)__builtin_amdgcn_kernarg_segment_ptr() + o)}; }
__device__ __forceinline__ void prologue_phase(const Ctx& C, const InRef& I, int L, const float* xsrc) {
    if (L == 0) fc_phase<true>(C, xsrc, nullptr, I.in(2) + (size_t)L * DM * IN_TOTAL, I.in(3) + (size_t)L * IN_TOTAL, (bf16*)(C.ws + WS_XB), C.ws + WS_XB8);
    else fc_phase<false>(C, nullptr, (const bf16*)(C.ws + WS_XB), I.in(2) + (size_t)L * DM * IN_TOTAL, I.in(3) + (size_t)L * IN_TOTAL, nullptr, C.ws + WS_XB8);
    LAS float* scr = (LAS float*)(C.lds + C.wave * 8448);
    const float* w_in = I.in(2) + (size_t)L * DM * IN_TOTAL;
    const float* w_br = I.in(14) + (size_t)L * 3 * 1024 * 2048;
    const float* w_o = I.in(15) + (size_t)L * 2048 * 2048;
    const float* w_q = I.in(18) + (size_t)L * 2048 * 1024;
    const float* w_ple = I.in(22) + (size_t)L * 256 * 2048;
    const float* w_pg = I.in(23) + (size_t)L * 2048 * 2048;
    bf16* WIN = (bf16*)(C.ws + WS_WIN); bf16* WV = (bf16*)(C.ws + WS_WV); bf16* WBR = (bf16*)(C.ws + WS_WBR); bf16* WO = (bf16*)(C.ws + WS_WO);
    bf16* WPGQ = (bf16*)(C.ws + WS_WPGQ); bf16* WPLE = (bf16*)(C.ws + WS_WPLE);
    constexpr int I_IN0 = 32 * 64, I_VA = 32 * 32, I_IN1 = 32 * 128, I_VC = 32 * 32, I_G = 32 * 192, I_BR = 16 * 64, I_O = 32 * 64, I_PG = 32 * 64, I_Q = 32 * 32, I_PLE = 4 * 64;
    constexpr int NITEMS = I_IN0 + I_VA + I_IN1 + I_VC + I_G + 3 * I_BR + I_O + I_PG + I_Q + I_PLE;
#define TJL(src, ldw, col0, K, ncols, dst, rowoff, ldt) { constexpr int ni_ = ((K) / 64) * ((ncols) / 32); if (r < ni_) { constexpr int nblk_ = (ncols) / 32; transpose_item(src, ldw, col0, K, dst, rowoff, scr, r / nblk_, r % nblk_, C.lane, ldt); continue; } r -= ni_; }
#define TJ(src, ldw, col0, K, ncols, dst, rowoff) TJL(src, ldw, col0, K, ncols, dst, rowoff, 0)
#define TJ8(src, ldw, col0, K, ncols, dst, rowoff) { constexpr int ni_ = ((K) / 64) * ((ncols) / 32); if (r < ni_) { constexpr int nblk_ = (ncols) / 32; transpose_item<true>(src, ldw, col0, K, dst, rowoff, scr, r / nblk_, r % nblk_, C.lane, K); continue; } r -= ni_; }
    for (int it = C.gw; it < NITEMS; it += C.NGW) {
        int r = it;
        TJ8(w_in, IN_TOTAL, 0, 2048, 2048, WIN, 0)
        TJ8(w_in, IN_TOTAL, 2048, 2048, 1024, WV, 0)
        TJ8(w_in, IN_TOTAL, 3072, 2048, 4096, WIN, 2048)
        TJ8(w_in, IN_TOTAL, 7168, 2048, 1024, WV, 1024)
        TJ8(w_in, IN_TOTAL, COL_GATE, 2048, 6144, WIN, 6144)
#define TJ8L(src, ldw, col0, K, ncols, dst, rowoff, ldt) { constexpr int ni_ = ((K) / 64) * ((ncols) / 32); if (r < ni_) { constexpr int nblk_ = (ncols) / 32; transpose_item<true>(src, ldw, col0, K, dst, rowoff, scr, r / nblk_, r % nblk_, C.lane, ldt); continue; } r -= ni_; }
        TJ8L(w_br, 2048, 0, 1024, 2048, WBR, 0, 3072)
        TJ8L(w_br + 1024 * 2048, 2048, 0, 1024, 2048, (bf16*)((unsigned char*)WBR + 1024), 0, 3072)
        TJ8L(w_br + 2 * 1024 * 2048, 2048, 0, 1024, 2048, (bf16*)((unsigned char*)WBR + 2048), 0, 3072)
        TJ8(w_o, 2048, 0, 2048, 2048, WO, 0)
        TJ8(w_pg, 2048, 0, 2048, 2048, WPGQ, 0)
        TJ(w_q, 1024, 0, 2048, 1024, WPGQ, 2048)
        TJ(w_ple, 2048, 0, 256, 2048, WPLE, 0)
    }
#undef TJ
#undef TJ8
#undef TJ8L
#undef TJL
    static_assert(I_IN0 == 2048 && I_G == 6144 && NITEMS > 0, "items");
    cvt_rows_fp4(C, I.in(20) + (size_t)L * NEXP * DM, C.ws + WS_PU, (float*)(C.ws + WS_SU), NEXP);
    cvt_rows_fp4(C, I.in(21) + (size_t)L * NEXP * DM, C.ws + WS_PV4, (float*)(C.ws + WS_SV4), NEXP);
    cvt_rows(C, I.in(19) + (size_t)L * 131072, (bf16*)(C.ws + WS_KEYS), 131072);
    cvt_rows(C, I.in(1) + (size_t)L * M * 256, (bf16*)(C.ws + WS_PB), (size_t)M * 256);
    { const float* wa = I.in(9) + (size_t)L * 131072; const float* wx = I.in(11) + (size_t)L * 131072;
      bf16* WLA = (bf16*)(C.ws + WS_WLA); bf16* WLX = (bf16*)(C.ws + WS_WLX);
      for (int o = C.bid * NTHR + C.tid; o < 131072; o += C.G * NTHR) { const int g = o >> 14, j = (o >> 7) & 127, i = o & 127; const int src = (g * 128 + i) * 128 + j;
          WLA[o] = (bf16)f2bf(wa[src]); WLX[o] = (bf16)f2bf(wx[src]); } }
}

constexpr int LRU_XC32 = 0, LRU_XCB = 32768, LRU_AA = 50176, LRU_SEG = 82944, LRU_CARRY = 87040;
__device__ __forceinline__ float gelu_tanh(float x) { const float y = 0.7978845608028654f * (x + 0.044715f * x * x * x); const float e = fexp(2.f * y); return x * (1.f - frcp(1.f + e)); }
template <bool FINAL>
__device__ __forceinline__ void lru_unit(const Ctx& C, const InRef& I, int L, int unit, bf16* Ydst) {
    const int g = unit & 7, chunk = (unit >> 3) & (LRU_NCH - 1), b = unit >> 10;
    const int tid = C.tid, lane = C.lane, wid = C.wave;
    const size_t tokbase = (size_t)b * SEQ; const int t0 = chunk * LRU_TC;
    LAS float* XC32 = (LAS float*)(C.lds + LRU_XC32); LAS unsigned char* XCB = C.lds + LRU_XCB; LAS float* AA = (LAS float*)(C.lds + LRU_AA);
    LAS f32x2* SEG = (LAS f32x2*)(C.lds + LRU_SEG); LAS float* CARRY = (LAS float*)(C.lds + LRU_CARRY);
    const bf16* BX = (const bf16*)(C.ws + WS_BX);
    const int seg = tid >> 7, cl = tid & 127, c = g * 128 + cl;
    bf16x8 wbr[8], wbx[8];
    { const int cb2 = wid & 3, r32 = lane & 31, hh = lane >> 5;
      const bf16* WLA = (const bf16*)(C.ws + WS_WLA) + (size_t)(g * 128 + cb2 * 32 + r32) * 128 + hh * 8;
      const bf16* WLX = (const bf16*)(C.ws + WS_WLX) + (size_t)(g * 128 + cb2 * 32 + r32) * 128 + hh * 8;
#pragma unroll
      for (int ks = 0; ks < 8; ++ks) { wbr[ks] = *(const bf16x8*)(WLA + ks * 16); wbx[ks] = *(const bf16x8*)(WLX + ks * 16); } }
    f32x2* LSUM = (f32x2*)(C.ws + WS_LSUM);
    unsigned short bgv[16];
    if constexpr (FINAL) {
        const bf16* BG = (const bf16*)(C.ws + WS_BG) + (tokbase + t0 + seg * 16) * 1024 + c;
#pragma unroll
        for (int i = 0; i < 16; ++i) bgv[i] = BG[(size_t)i * 1024];
        const int per = (chunk + 3) >> 2, klo = seg * per, khi = (klo + per < chunk) ? klo + per : chunk;
        float A = 1.f, H = 0.f; const f32x2* lp = LSUM + (size_t)(b * LRU_NCH) * 1024 + c;
#pragma unroll 8
        for (int k = klo; k < khi; ++k) { const f32x2 v = lp[(size_t)k * 1024]; H = v[0] * H + v[1]; A *= v[0]; }
        ((LAS f32x2*)(C.lds + LRU_CARRY + 512))[seg * 128 + cl] = (f32x2){A, H};
    }
    {
        const int tr = tid >> 3, cb = tid & 7, c0 = g * 128 + cb * 16;
        const float* cw = I.in(7) + (size_t)L * 4 * 1024 + c0; const float* cbp = I.in(8) + (size_t)L * 1024 + c0;
        u32x4 xin[4][2]; f32x4 wt[4][4], bia[4]; float msk[4];
#pragma unroll
        for (int tap = 0; tap < 4; ++tap) { const int sq = t0 + tr - 3 + tap; msk[tap] = sq < 0 ? 0.f : 1.f; const bf16* xp = BX + (tokbase + (sq < 0 ? 0 : sq)) * 1024 + c0;
            xin[tap][0] = *(const u32x4*)xp; xin[tap][1] = *(const u32x4*)(xp + 8);
#pragma unroll
            for (int q = 0; q < 4; ++q) wt[tap][q] = *(const f32x4*)(cw + tap * 1024 + 4 * q); }
#pragma unroll
        for (int q = 0; q < 4; ++q) bia[q] = *(const f32x4*)(cbp + 4 * q);
        __builtin_amdgcn_sched_barrier(0);
        float acc[16];
#pragma unroll
        for (int q = 0; q < 4; ++q) { acc[4 * q] = bia[q][0]; acc[4 * q + 1] = bia[q][1]; acc[4 * q + 2] = bia[q][2]; acc[4 * q + 3] = bia[q][3]; }
#pragma unroll
        for (int tap = 0; tap < 4; ++tap) { const u32x4 x0 = xin[tap][0], x1 = xin[tap][1]; const float mk = msk[tap];
            const float xv[16] = {bflo(x0.x), bfhi(x0.x), bflo(x0.y), bfhi(x0.y), bflo(x0.z), bfhi(x0.z), bflo(x0.w), bfhi(x0.w),
                                  bflo(x1.x), bfhi(x1.x), bflo(x1.y), bfhi(x1.y), bflo(x1.z), bfhi(x1.z), bflo(x1.w), bfhi(x1.w)};
#pragma unroll
            for (int q = 0; q < 4; ++q) { const f32x4 w = wt[tap][q] * mk;
                acc[4 * q] += xv[4 * q] * w[0]; acc[4 * q + 1] += xv[4 * q + 1] * w[1]; acc[4 * q + 2] += xv[4 * q + 2] * w[2]; acc[4 * q + 3] += xv[4 * q + 3] * w[3]; } }
#pragma unroll
        for (int q = 0; q < 4; ++q) *(LAS f32x4*)(XC32 + tr * 128 + cb * 16 + 4 * q) = (f32x4){acc[4 * q], acc[4 * q + 1], acc[4 * q + 2], acc[4 * q + 3]};
        u32x4 p0, p1;
        p0.x = pk2(acc[0], acc[1]); p0.y = pk2(acc[2], acc[3]); p0.z = pk2(acc[4], acc[5]); p0.w = pk2(acc[6], acc[7]);
        p1.x = pk2(acc[8], acc[9]); p1.y = pk2(acc[10], acc[11]); p1.z = pk2(acc[12], acc[13]); p1.w = pk2(acc[14], acc[15]);
        *(LAS u32x4*)(XCB + tr * 272 + cb * 32) = p0; *(LAS u32x4*)(XCB + tr * 272 + cb * 32 + 16) = p1;
    }
    __syncthreads();
    {
        if constexpr (FINAL) {
            if (tid < 128) { float hin = 0.f; const LAS f32x2* LB = (const LAS f32x2*)(C.lds + LRU_CARRY + 512);
#pragma unroll
                for (int sg = 0; sg < 4; ++sg) { const f32x2 v = LB[sg * 128 + tid]; hin = v[0] * hin + v[1]; }
                CARRY[tid] = hin; } }
        const int tb = wid >> 2, cb2 = wid & 3, r32 = lane & 31, hh = lane >> 5;
        f32x16 accr = {}, accx = {};
#pragma unroll
        for (int ks = 0; ks < 8; ++ks) {
            const bf16x8 a = *(const LAS bf16x8*)(XCB + (tb * 32 + r32) * 272 + (ks * 16 + hh * 8) * 2);
            accr = __builtin_amdgcn_mfma_f32_32x32x16_bf16(a, wbr[ks], accr, 0, 0, 0);
            accx = __builtin_amdgcn_mfma_f32_32x32x16_bf16(a, wbx[ks], accx, 0, 0, 0);
        }
        const int cl = cb2 * 32 + r32, c = g * 128 + cl;
        const float ba = I.in(10)[(size_t)L * 1024 + c], bxx = I.in(12)[(size_t)L * 1024 + c], lam = I.in(13)[(size_t)L * 1024 + c];
        const float lsl = flog_sigmoid(lam);
#pragma unroll
        for (int r = 0; r < 16; ++r) {
            const int t = tb * 32 + (r & 3) + 8 * (r >> 2) + 4 * hh;
            const float rr = fast_sigmoid(accr[r] + ba), gi = fast_sigmoid(accx[r] + bxx);
            const float la2 = (8.0f * LOG2E) * rr * lsl;
            const float a = __builtin_amdgcn_exp2f(la2), mult = __builtin_amdgcn_sqrtf(fmaxf(1.f - a * a, 0.f));
            const float xcv = XC32[t * 128 + cl];
            const float uval = mult * (gi * xcv);
            AA[t * 128 + cl] = a; XC32[t * 128 + cl] = uval;
            if constexpr (!FINAL) ((unsigned*)(C.ws + WS_AU))[(tokbase + t0 + t) * 1024 + c] = f2bf(la2) | (f2bf(uval) << 16);
        }
    }
    __syncthreads();
    {
        float Ap = 1.f, H = 0.f;
#pragma unroll
        for (int i = 0; i < 16; ++i) { const int t = seg * 16 + i; const float a = AA[t * 128 + cl], u = XC32[t * 128 + cl]; H = a * H + u; Ap *= a; }
        SEG[seg * 128 + cl] = (f32x2){Ap, H};
    }
    __syncthreads();
    if constexpr (!FINAL) {
        if (tid < 128) { float A = 1.f, H = 0.f;
#pragma unroll
            for (int s = 0; s < 4; ++s) { const f32x2 v = SEG[s * 128 + cl]; H = v[0] * H + v[1]; A *= v[0]; }
            LSUM[(size_t)(b * LRU_NCH + chunk) * 1024 + c] = (f32x2){A, H}; }
    } else {
        float h = CARRY[cl];
        for (int s = 0; s < seg; ++s) { const f32x2 v = SEG[s * 128 + cl]; h = v[0] * h + v[1]; }
        bf16* YB = Ydst + (tokbase + t0 + seg * 16) * 3072 + c;
#pragma unroll
        for (int i = 0; i < 16; ++i) { const int t = seg * 16 + i; h = AA[t * 128 + cl] * h + XC32[t * 128 + cl];
            YB[(size_t)i * 3072] = (bf16)f2bf(gelu_tanh(bflo((unsigned)bgv[i])) * h); }
    }
    __syncthreads();
}

__device__ __forceinline__ void lru_final_unit(const Ctx& C, int unit, unsigned char* Ydst) {
    const int g = unit & 7, chunk = (unit >> 3) & (LRU_NCH - 1), b = unit >> 10;
    const int tid = C.tid, seg = tid >> 7, cl = tid & 127, c = g * 128 + cl;
    const size_t tokbase = (size_t)b * SEQ; const int t0 = chunk * LRU_TC;
    const size_t row0 = tokbase + t0 + seg * 16;
    const unsigned* AU = (const unsigned*)(C.ws + WS_AU) + row0 * 1024 + c;
    const bf16* BG = (const bf16*)(C.ws + WS_BG) + row0 * 1024 + c;
    unsigned au[16]; unsigned short bgv[16];
#pragma unroll
    for (int i = 0; i < 16; ++i) { au[i] = AU[(size_t)i * 1024]; bgv[i] = BG[(size_t)i * 1024]; }
    LAS f32x2* SEG = (LAS f32x2*)(C.lds + LRU_SEG); LAS f32x2* LB = (LAS f32x2*)(C.lds + LRU_CARRY + 512);
    { const f32x2* LSUM = (const f32x2*)(C.ws + WS_LSUM);
      const int per = (chunk + 3) >> 2, klo = seg * per, khi = (klo + per < chunk) ? klo + per : chunk;
      float A = 1.f, H = 0.f; const f32x2* lp = LSUM + (size_t)(b * LRU_NCH) * 1024 + c;
#pragma unroll 8
      for (int k = klo; k < khi; ++k) { const f32x2 v = lp[(size_t)k * 1024]; H = v[0] * H + v[1]; A *= v[0]; }
      LB[seg * 128 + cl] = (f32x2){A, H}; }
    float av[16], uv[16];
    { float Ap = 1.f, H = 0.f;
#pragma unroll
      for (int i = 0; i < 16; ++i) { av[i] = __builtin_amdgcn_exp2f(bflo(au[i])); uv[i] = bfhi(au[i]); H = av[i] * H + uv[i]; Ap *= av[i]; }
      SEG[seg * 128 + cl] = (f32x2){Ap, H}; }
    __syncthreads();
    float h = 0.f;
#pragma unroll
    for (int sg = 0; sg < 4; ++sg) { const f32x2 v = LB[sg * 128 + cl]; h = v[0] * h + v[1]; }
    for (int sg = 0; sg < seg; ++sg) { const f32x2 v = SEG[sg * 128 + cl]; h = v[0] * h + v[1]; }
    unsigned char* YB = Ydst + row0 * 3072 + c;
#pragma unroll
    for (int i = 0; i < 16; ++i) { h = av[i] * h + uv[i]; const float y8 = __builtin_amdgcn_fmed3f(8.f * gelu_tanh(bflo((unsigned)bgv[i])) * h, -448.f, 448.f); YB[(size_t)i * 3072] = (unsigned char)__builtin_amdgcn_cvt_pk_fp8_f32(y8, y8, 0, false); }
    __syncthreads();
}

__device__ __forceinline__ void kmax_phase(const Ctx& C, int L) {
    const bf16* KC = (const bf16*)(C.ws + WS_KC); LAS float* red = (LAS float*)(C.lds + 120 * 1024);
    const int lane = C.lane;
    for (int rb = C.bid; rb < M / 64; rb += C.G) {
        float mx = 0.f;
#pragma unroll
        for (int r = 0; r < 8; ++r) { const bf16* kp = KC + (size_t)(rb * 64 + C.wave * 8 + r) * 1024 + 16 * lane;
            const u32x4 a = *(const u32x4*)kp, b = *(const u32x4*)(kp + 8); float q = 0.f;
#pragma unroll
            for (int i = 0; i < 4; ++i) { q += bflo(a[i]) * bflo(a[i]) + bfhi(a[i]) * bfhi(a[i]); q += bflo(b[i]) * bflo(b[i]) + bfhi(b[i]) * bfhi(b[i]); }
            q += __shfl_xor(q, 1); q += __shfl_xor(q, 2); q += __shfl_xor(q, 4); mx = fmaxf(mx, q); }
        __syncthreads();
        if ((lane & 7) == 0) red[C.wave * 8 + (lane >> 3)] = mx;
        __syncthreads();
        if (C.tid < 8) { float v = red[C.tid];
#pragma unroll
            for (int w = 1; w < 8; ++w) v = fmaxf(v, red[w * 8 + C.tid]);
            const int b = (rb * 64) / SEQ;
            __hip_atomic_fetch_max((unsigned*)(C.ctl + CW_KMAX + 16 * L + b * 8 + C.tid), __builtin_bit_cast(unsigned, v), RLX_AGENT); }
    }
}

constexpr int AT_KT = 0, AT_KPITCH = 272, AT_KBYTES = 64 * 272, AT_VT = 2 * AT_KBYTES, AT_VPITCH = 144, AT_VBYTES = 128 * 144, AT_CK = AT_VT + 2 * AT_VBYTES, AT_TAB = AT_CK + 512;
#define MFMA32(a, b, c) __builtin_amdgcn_mfma_f32_32x32x16_bf16((a), (b), (c), 0, 0, 0)
template <int MODE>
__device__ __forceinline__ void attn_unit(const Ctx& C, const InRef& I, int L, int b, int h, int qb, unsigned char* Odst) {
    constexpr int KS = MODE == 0 ? 4 : 8, QB = MODE == 0 ? 128 : 256;
    const int tid = C.tid, wid = C.wave, lane = C.lane, qi = lane & 31, hh = lane >> 5;
    const int cw = MODE == 0 ? (wid & 1) : 0, qg = MODE == 0 ? (wid >> 1) : wid;
    bf16* Q = (bf16*)(C.ws + (MODE == 0 ? WS_QA : WS_QC));
    const bf16* K = (const bf16*)(C.ws + (MODE == 0 ? WS_KA : WS_KC));
    const bf16* VT = (const bf16*)(C.ws + WS_VT) + (size_t)(MODE == 0 ? 0 : 1024) * M;
    const float* CUM2 = (const float*)(C.ws + WS_CUM2) + (size_t)(b * 8 + h) * SEQ;
    const size_t tokbase = (size_t)b * SEQ;
    const int q0 = qb * QB + qg * 32, qpos = q0 + qi;
    LAS unsigned char* lds = C.lds;
    LAS float* TAB = (LAS float*)(lds + AT_TAB);
    float c31 = 0.f, cq2 = 0.f, lam = 0.f;
    const float lam_init = L == 0 ? 0.2f : 0.35550907f;
    if constexpr (MODE == 0) {
        const float* rel = I.in(6);
        if (tid < 128) { const int n = tid; int bk = n;
            if (n >= 16) { bk = 16 + (int)(__builtin_amdgcn_logf((float)n * 0.0625f) * (16.f / 3.f));     bk = bk > 31 ? 31 : bk; }
            TAB[n] = rel[bk * 8 + h] * LOG2E; }
        c31 = rel[31 * 8 + h] * LOG2E;
        const float* lv = I.in(4) + (size_t)L * 256;
        const float s1 = wave_sum(lv[lane] * lv[64 + lane]), s2 = wave_sum(lv[128 + lane] * lv[192 + lane]);
        lam = fexp(s1) - fexp(s2) + lam_init;
    } else { cq2 = CUM2[qpos]; }
    bf16x8 qf[KS];
    { const bf16* qp = Q + (tokbase + qpos) * 1024 + h * 128 + cw * 64 + hh * 8;
#pragma unroll
      for (int ks = 0; ks < KS; ++ks) qf[ks] = *(const bf16x8*)(qp + ks * 16); }
    f32x16 o[4]; float mrun = -1e30f, lrun = 0.f;
#pragma unroll
    for (int d = 0; d < 4; ++d) o[d] = (f32x16){};
    const int NT = (qb + 1) * (QB / 64);
    float B0 = 0.f; bool wdone = false;
    if constexpr (MODE == 1) {
        float ssq = 0.f;
#pragma unroll
        for (int ks = 0; ks < KS; ++ks)
#pragma unroll
            for (int j = 0; j < 8; ++j) { const float v = __builtin_bit_cast(float, (unsigned)(unsigned short)qf[ks][j] << 16); ssq += v * v; }
        ssq += __shfl_xor(ssq, 32);
#pragma unroll
        for (int of = 1; of < 32; of <<= 1) ssq = fmaxf(ssq, __shfl_xor(ssq, of));
        const float kmax2 = __builtin_bit_cast(float, __hip_atomic_load((unsigned*)(C.ctl + CW_KMAX + 16 * L + b * 8 + h), RLX_AGENT));
        B0 = __builtin_amdgcn_sqrtf(ssq * kmax2) * 1.0001f + 1.0f;
    }
    const int krow = tid >> 4, kch = tid & 15, vrow = tid >> 3, vch = tid & 7;
    const char* Ku = (const char*)(K + tokbase * 1024 + h * 128); const unsigned koff = (unsigned)(krow * 1024 + kch * 8) * 2u;
    const char* Vu = (const char*)(VT + (size_t)(h * 128) * M + tokbase); const unsigned voff = (unsigned)(vrow * M + vch * 8) * 2u;
    u32x4 sk0, sk1, sv0, sv1; float sck = 0.f;
#define AT_LOAD(k0_) do { const char* kp_ = Ku + (size_t)(k0_) * 2048; const char* vp2_ = Vu + (size_t)(k0_) * 2; sk0 = *(const u32x4*)(kp_ + koff); sk1 = *(const u32x4*)(kp_ + 32 * 2048 + koff); \
        sv0 = *(const u32x4*)(vp2_ + voff); sv1 = *(const u32x4*)(vp2_ + (size_t)64 * M * 2 + voff); if (MODE == 1 && tid < 64) sck = CUM2[(k0_) + tid]; } while (0)
    AT_LOAD(MODE == 1 ? (NT - 1) * 64 : 0);
    const int kr = (qi & 19) | ((qi & 4) << 1) | ((qi & 8) >> 1);
    for (int it = 0; it < NT; ++it) {
        const int t = MODE == 1 ? NT - 1 - it : it;
        const int buf = it & 1, k0 = t * 64;
        LAS unsigned char* kt = lds + AT_KT + buf * AT_KBYTES; LAS unsigned char* vt = lds + AT_VT + buf * AT_VBYTES; LAS float* ck = (LAS float*)(lds + AT_CK + buf * 256);
        *(LAS u32x4*)(kt + krow * AT_KPITCH + kch * 16) = sk0; *(LAS u32x4*)(kt + (krow + 32) * AT_KPITCH + kch * 16) = sk1;
        *(LAS u32x4*)(vt + vrow * AT_VPITCH + vch * 16) = sv0; *(LAS u32x4*)(vt + (vrow + 64) * AT_VPITCH + vch * 16) = sv1;
        if (MODE == 1 && tid < 64) ck[tid] = sck;
        __syncthreads();
        if constexpr (MODE == 1) {
            if (it > 0) { const LAS int* fl = (const LAS int*)(lds + AT_TAB) + ((it - 1) & 1) * 8;
                if (fl[0] & fl[1] & fl[2] & fl[3] & fl[4] & fl[5] & fl[6] & fl[7]) break; }
        }
        if (it + 1 < NT) AT_LOAD(MODE == 1 ? k0 - 64 : k0 + 64);
        bool act = (k0 <= q0);
        if constexpr (MODE == 1) {
            if (act && !wdone) { const float D = __shfl(cq2, 0) - ck[63]; float mmin = mrun;
#pragma unroll
                for (int of = 1; of < 64; of <<= 1) mmin = fminf(mmin, __shfl_xor(mmin, of));
                if (B0 + D < mmin - 40.f) wdone = true; }
            if (lane == 0) ((LAS int*)(lds + AT_TAB))[(it & 1) * 8 + wid] = wdone ? 1 : 0;
            act = act && !wdone;
        }
        if (act) {
            f32x16 s[2]; s[0] = (f32x16){}; s[1] = (f32x16){};
#pragma unroll
            for (int ks = 0; ks < KS; ++ks) {
                const LAS unsigned char* ap = kt + kr * AT_KPITCH + (cw * 64 + ks * 16 + hh * 8) * 2;
                const bf16x8 a0 = *(const LAS bf16x8*)ap, a1 = *(const LAS bf16x8*)(ap + 32 * AT_KPITCH);
                s[0] = MFMA32(a0, qf[ks], s[0]); s[1] = MFMA32(a1, qf[ks], s[1]);
            }
            if constexpr (MODE == 0) {
                if (k0 + 63 + 128 > q0) {
#pragma unroll
                    for (int kb = 0; kb < 2; ++kb)
#pragma unroll
                        for (int r = 0; r < 16; ++r) { const int key = k0 + kb * 32 + 16 * (r >> 3) + 8 * hh + (r & 7), dist = qpos - key;
                            const int di = dist < 0 ? 0 : (dist > 127 ? 127 : dist);
                            const float v = s[kb][r] + TAB[di]; s[kb][r] = dist < 0 ? -__builtin_inff() : v; }
                } else {
#pragma unroll
                    for (int kb = 0; kb < 2; ++kb)
#pragma unroll
                        for (int r = 0; r < 16; ++r) s[kb][r] += c31;
                }
            } else {
#pragma unroll
                for (int kb = 0; kb < 2; ++kb)
#pragma unroll
                    for (int r = 0; r < 16; ++r) { const int kl = kb * 32 + 16 * (r >> 3) + 8 * hh + (r & 7);
                        const float v = s[kb][r] + (cq2 - ck[kl]); s[kb][r] = (k0 + kl > qpos) ? -__builtin_inff() : v; }
            }
            float mx = s[0][0];
#pragma unroll
            for (int r = 1; r < 16; ++r) mx = fmaxf(mx, s[0][r]);
#pragma unroll
            for (int r = 0; r < 16; ++r) mx = fmaxf(mx, s[1][r]);
            mx = fmaxf(mx, __shfl_xor(mx, 32));
            const float mnew = fmaxf(mrun, mx), alpha = __builtin_amdgcn_exp2f(mrun - mnew);
            mrun = mnew;
            float ps = 0.f;
#pragma unroll
            for (int kb = 0; kb < 2; ++kb)
#pragma unroll
                for (int r = 0; r < 16; ++r) { const float p = __builtin_amdgcn_exp2f(s[kb][r] - mnew); s[kb][r] = p; ps += p; }
            lrun = lrun * alpha + ps;
            if (!__all(alpha == 1.f)) {
#pragma unroll
                for (int d = 0; d < 4; ++d)
#pragma unroll
                    for (int r = 0; r < 16; ++r) o[d][r] *= alpha;
            }
            bf16x8 pf[2][2];
#pragma unroll
            for (int kb = 0; kb < 2; ++kb)
#pragma unroll
                for (int s2 = 0; s2 < 2; ++s2) { u32x4 w;
                    w.x = cvtpk(s[kb][8 * s2 + 0], s[kb][8 * s2 + 1]); w.y = cvtpk(s[kb][8 * s2 + 2], s[kb][8 * s2 + 3]);
                    w.z = cvtpk(s[kb][8 * s2 + 4], s[kb][8 * s2 + 5]); w.w = cvtpk(s[kb][8 * s2 + 6], s[kb][8 * s2 + 7]);
                    pf[kb][s2] = __builtin_bit_cast(bf16x8, w); }
#pragma unroll
            for (int kb = 0; kb < 2; ++kb)
#pragma unroll
                for (int s2 = 0; s2 < 2; ++s2)
#pragma unroll
                    for (int d = 0; d < 4; ++d) {
                        const bf16x8 a = *(const LAS bf16x8*)(vt + (d * 32 + qi) * AT_VPITCH + (kb * 32 + s2 * 16 + hh * 8) * 2);
                        o[d] = MFMA32(a, pf[kb][s2], o[d]);
                    }
        }
    }
#undef AT_LOAD
    unsigned char* Op = Odst + (tokbase + qpos) * 3072 + h * 128 + 4 * hh;
    const float ltot = lrun + __shfl_xor(lrun, 32);
    if constexpr (MODE == 0) {
        LAS float* X = (LAS float*)(lds + qg * 16384);
        __syncthreads();
        if (cw == 1) { const float i1 = lam * frcp(ltot);
#pragma unroll
            for (int d = 0; d < 4; ++d)
#pragma unroll
                for (int r = 0; r < 16; ++r) X[(d * 16 + r) * 64 + lane] = o[d][r] * i1; }
        __syncthreads();
        if (cw == 0) {
            const float i0 = frcp(ltot); float ss = 0.f;
#pragma unroll
            for (int d = 0; d < 4; ++d)
#pragma unroll
                for (int r = 0; r < 16; ++r) { const float y = o[d][r] * i0 - X[(d * 16 + r) * 64 + lane]; o[d][r] = y; ss += y * y; }
            ss += __shfl_xor(ss, 32);
            const float rs = frsq(ss * (1.f / 128.f) + LN_EPS) * (1.f - lam_init);
            const float* sub = I.in(5) + (size_t)L * 128 + 4 * hh;
#pragma unroll
            for (int d = 0; d < 4; ++d)
#pragma unroll
                for (int g4 = 0; g4 < 4; ++g4) { const f32x4 w = *(const f32x4*)(sub + d * 32 + 8 * g4);
                    *(unsigned*)(Op + d * 32 + 8 * g4) = pack4_fp8(o[d][4 * g4] * rs * w[0], o[d][4 * g4 + 1] * rs * w[1], o[d][4 * g4 + 2] * rs * w[2], o[d][4 * g4 + 3] * rs * w[3], 8.f); }
        }
    } else {
        const float i0 = frcp(ltot);
#pragma unroll
        for (int d = 0; d < 4; ++d)
#pragma unroll
            for (int g4 = 0; g4 < 4; ++g4) {
                *(unsigned*)(Op + d * 32 + 8 * g4) = pack4_fp8(o[d][4 * g4] * i0, o[d][4 * g4 + 1] * i0, o[d][4 * g4 + 2] * i0, o[d][4 * g4 + 3] * i0, 8.f); }
    }
}

__device__ __forceinline__ float max3f(float a, float b, float c) { float r; asm("v_max3_f32 %0, %1, %2, %3" : "=v"(r) : "v"(a), "v"(b), "v"(c)); return r; }
__device__ __forceinline__ void attn_diff_unit(const Ctx& C, const InRef& I, int L, int b, int h, int qb, unsigned char* Odst) {
    const int tid = C.tid, wid = C.wave, lane = C.lane, qi = lane & 31, hh = lane >> 5;
    const int cw = wid & 1, qg = wid >> 1;
    const bf16* Q = (const bf16*)(C.ws + WS_QA); const bf16* K = (const bf16*)(C.ws + WS_KA); const bf16* VT = (const bf16*)(C.ws + WS_VT);
    const size_t tokbase = (size_t)b * SEQ;
    const int q0 = qb * 128 + qg * 32, qpos = q0 + qi;
    LAS unsigned char* lds = C.lds;
    LAS float* TAB = (LAS float*)(lds + AT_TAB);
    const float lam_init = L == 0 ? 0.2f : 0.35550907f;
    const float* rel = I.in(6);
    if (tid < 128) { const int n = tid; int bk = n;
        if (n >= 16) { bk = 16 + (int)(__builtin_amdgcn_logf((float)n * 0.0625f) * (16.f / 3.f));     bk = bk > 31 ? 31 : bk; }
        TAB[n] = (rel[bk * 8 + h] - rel[31 * 8 + h]) * LOG2E; }
    const float c31 = rel[31 * 8 + h] * LOG2E;
    float lam;
    { const float* lv = I.in(4) + (size_t)L * 256;
      const float s1 = wave_sum(lv[lane] * lv[64 + lane]), s2 = wave_sum(lv[128 + lane] * lv[192 + lane]);
      lam = fexp(s1) - fexp(s2) + lam_init; }
    LAS unsigned char* qlds = lds + AT_TAB + 512 + wid * 4096 + lane * 16;
    { const bf16* qp = Q + (tokbase + qpos) * 1024 + h * 128 + cw * 64 + hh * 8;
#pragma unroll
      for (int ks = 0; ks < 4; ++ks) *(LAS bf16x8*)(qlds + ks * 1024) = *(const bf16x8*)(qp + ks * 16); }
    f32x16 o[4]; float mrun = -1e30f, lrun = 0.f;
#pragma unroll
    for (int d = 0; d < 4; ++d) o[d] = (f32x16){};
    const int NT = (qb + 1) * 2;
    const int krow = tid >> 4, kch = tid & 15, vrow = tid >> 3, vch = tid & 7;
    const char* Ku = (const char*)(K + tokbase * 1024 + h * 128); const unsigned koff = (unsigned)(krow * 1024 + kch * 8) * 2u;
    const char* Vu = (const char*)(VT + (size_t)(h * 128) * M + tokbase); const unsigned voff = (unsigned)(vrow * M + vch * 8) * 2u;
    const int kr = (qi & 19) | ((qi & 4) << 1) | ((qi & 8) >> 1);
    const int kaoff = kr * AT_KPITCH + (cw * 64 + hh * 8) * 2, vaoff = qi * AT_VPITCH + hh * 16;
    u32x4 sk0, sk1, sv0, sv1;
#define DA_LOADK(k0_) do { const char* kp_ = Ku + (size_t)(k0_) * 2048; sk0 = *(const u32x4*)(kp_ + koff); sk1 = *(const u32x4*)(kp_ + 32 * 2048 + koff); } while (0)
#define DA_LOADV(k0_) do { const char* vp2_ = Vu + (size_t)(k0_) * 2; sv0 = *(const u32x4*)(vp2_ + voff); sv1 = *(const u32x4*)(vp2_ + (size_t)64 * M * 2 + voff); } while (0)
#define DA_WRITEK(bf_) do { LAS unsigned char* kt_ = lds + AT_KT + (bf_) * AT_KBYTES; *(LAS u32x4*)(kt_ + krow * AT_KPITCH + kch * 16) = sk0; *(LAS u32x4*)(kt_ + (krow + 32) * AT_KPITCH + kch * 16) = sk1; } while (0)
#define DA_WRITEV(bf_) do { LAS unsigned char* vt_ = lds + AT_VT + (bf_) * AT_VBYTES; *(LAS u32x4*)(vt_ + vrow * AT_VPITCH + vch * 16) = sv0; *(LAS u32x4*)(vt_ + (vrow + 64) * AT_VPITCH + vch * 16) = sv1; } while (0)
#define DA_QK(S0, S1, MU, bf_) do { const LAS unsigned char* ap_ = lds + AT_KT + (bf_) * AT_KBYTES + kaoff; MU = cref; \
        _Pragma("unroll") for (int ks = 0; ks < 4; ++ks) { const bf16x8 a0 = *(const LAS bf16x8*)(ap_ + ks * 32), a1 = *(const LAS bf16x8*)(ap_ + ks * 32 + 32 * AT_KPITCH); \
            const bf16x8 qk_ = *(const LAS bf16x8*)(qlds + ks * 1024); S0 = MFMA32(a0, qk_, ks ? S0 : CI); S1 = MFMA32(a1, qk_, ks ? S1 : CI); } } while (0)
#define SB() __builtin_amdgcn_sched_barrier(0)
#define DA_RD1(dst, addr, off) asm volatile("ds_read_b128 %0, %1 offset:%2" : "=v"(dst) : "v"(addr), "i"(off) : "memory")
#define DA_RD4(a0, a1, a2, a3, addr, off) do { DA_RD1(a0, addr, (off)); DA_RD1(a1, addr, (off) + 32 * AT_VPITCH); DA_RD1(a2, addr, (off) + 64 * AT_VPITCH); DA_RD1(a3, addr, (off) + 96 * AT_VPITCH); } while (0)
#define DA_SMPV(S0, S1, MU, k0_, bf_) do { \
        float mx; \
        if ((k0_) + 63 + 113 > q0) {   \
            int qrel_ = qpos - 8 * hh - (k0_); asm volatile("" : "+v"(qrel_));     \
            _Pragma("unroll") for (int r = 0; r < 16; ++r) { const int d0 = qrel_ - (16 * (r >> 3) + (r & 7)), d1 = d0 - 32; \
                const float v0 = S0[r] + TAB[d0 < 0 ? 0 : (d0 > 127 ? 127 : d0)], v1 = S1[r] + TAB[d1 < 0 ? 0 : (d1 > 127 ? 127 : d1)]; \
                S0[r] = d0 < 0 ? -__builtin_inff() : v0; S1[r] = d1 < 0 ? -__builtin_inff() : v1; } \
            } \
        mx = fmaxf(S0[0], S1[0]); \
        _Pragma("unroll") for (int r = 1; r < 16; ++r) mx = max3f(mx, S0[r], S1[r]); \
        mx = fmaxf(mx, __shfl_xor(mx, 32)) + MU;            \
          \
        const bool keep_ = __all(mx - mrun <= 8.f); \
        const float mnew = keep_ ? mrun : fmaxf(mrun, mx), alpha = keep_ ? 1.f : __builtin_amdgcn_exp2f(mrun - mnew), sh = MU - mnew; mrun = mnew; \
        if (!__all(sh == 0.f)) { _Pragma("unroll") for (int r = 0; r < 16; ++r) { S0[r] += sh; S1[r] += sh; } }     \
        if (!keep_) { cref = mrun; _Pragma("unroll") for (int r = 0; r < 16; ++r) CI[r] = c31 - cref; } \
        float ps = 0.f; \
        _Pragma("unroll") for (int r = 0; r < 16; ++r) { S0[r] = __builtin_amdgcn_exp2f(S0[r]); S1[r] = __builtin_amdgcn_exp2f(S1[r]); ps += S0[r] + S1[r]; } \
        lrun = lrun * alpha + ps; \
        if (!keep_) { _Pragma("unroll") for (int d = 0; d < 4; ++d) _Pragma("unroll") for (int r = 0; r < 16; ++r) o[d][r] *= alpha; } \
        bf16x8 pf[4]; \
        _Pragma("unroll") for (int s2 = 0; s2 < 2; ++s2) { u32x4 w0, w1; \
            w0.x = cvtpk(S0[8 * s2 + 0], S0[8 * s2 + 1]); w0.y = cvtpk(S0[8 * s2 + 2], S0[8 * s2 + 3]); w0.z = cvtpk(S0[8 * s2 + 4], S0[8 * s2 + 5]); w0.w = cvtpk(S0[8 * s2 + 6], S0[8 * s2 + 7]); \
            w1.x = cvtpk(S1[8 * s2 + 0], S1[8 * s2 + 1]); w1.y = cvtpk(S1[8 * s2 + 2], S1[8 * s2 + 3]); w1.z = cvtpk(S1[8 * s2 + 4], S1[8 * s2 + 5]); w1.w = cvtpk(S1[8 * s2 + 6], S1[8 * s2 + 7]); \
            pf[s2] = __builtin_bit_cast(bf16x8, w0); pf[2 + s2] = __builtin_bit_cast(bf16x8, w1); } \
          \
        { const unsigned va_ = (unsigned)(unsigned long)(lds + AT_VT + (bf_) * AT_VBYTES + vaoff); bf16x8 f0, f1, f2, f3, g0, g1, g2, g3; \
          DA_RD4(f0, f1, f2, f3, va_, 0); DA_RD4(g0, g1, g2, g3, va_, 32); \
          asm volatile("s_waitcnt lgkmcnt(4)" ::: "memory"); SB(); \
          o[0] = MFMA32(f0, pf[0], o[0]); o[1] = MFMA32(f1, pf[0], o[1]); o[2] = MFMA32(f2, pf[0], o[2]); o[3] = MFMA32(f3, pf[0], o[3]); SB(); \
          DA_RD4(f0, f1, f2, f3, va_, 64); \
          asm volatile("s_waitcnt lgkmcnt(4)" ::: "memory"); SB(); \
          o[0] = MFMA32(g0, pf[1], o[0]); o[1] = MFMA32(g1, pf[1], o[1]); o[2] = MFMA32(g2, pf[1], o[2]); o[3] = MFMA32(g3, pf[1], o[3]); SB(); \
          DA_RD4(g0, g1, g2, g3, va_, 96); \
          asm volatile("s_waitcnt lgkmcnt(4)" ::: "memory"); SB(); \
          o[0] = MFMA32(f0, pf[2], o[0]); o[1] = MFMA32(f1, pf[2], o[1]); o[2] = MFMA32(f2, pf[2], o[2]); o[3] = MFMA32(f3, pf[2], o[3]); SB(); \
          asm volatile("s_waitcnt lgkmcnt(0)" ::: "memory"); SB(); \
          o[0] = MFMA32(g0, pf[3], o[0]); o[1] = MFMA32(g1, pf[3], o[1]); o[2] = MFMA32(g2, pf[3], o[2]); o[3] = MFMA32(g3, pf[3], o[3]); SB(); } } while (0)
#define DA_STEP(t_, SC0, SC1, MUC, SN0, SN1, MUN) do { const int k0 = (t_) * 64; \
        if ((t_) + 1 < NT) DA_WRITEK(((t_) + 1) & 1); DA_WRITEV((t_) & 1); \
        __syncthreads(); \
        if ((t_) + 2 < NT) DA_LOADK(k0 + 128); if ((t_) + 1 < NT) DA_LOADV(k0 + 64); \
        const bool act_ = k0 <= q0, actn_ = ((t_) + 1 < NT) && (k0 + 64 <= q0); \
        if (actn_) DA_QK(SN0, SN1, MUN, ((t_) + 1) & 1); \
        if (act_) DA_SMPV(SC0, SC1, MUC, k0, (t_) & 1); } while (0)
    f32x16 sa0, sa1, sb0, sb1, CI; float cref = 0.f, mua = 0.f, mub = 0.f;
#pragma unroll
    for (int r = 0; r < 16; ++r) CI[r] = c31;
    DA_LOADK(0); DA_WRITEK(0); DA_LOADK(64); DA_LOADV(0);
    __syncthreads();
    DA_QK(sa0, sa1, mua, 0);
    for (int t = 0; t < NT; t += 2) { DA_STEP(t, sa0, sa1, mua, sb0, sb1, mub); DA_STEP(t + 1, sb0, sb1, mub, sa0, sa1, mua); }
#undef DA_LOADK
#undef DA_LOADV
#undef DA_WRITEK
#undef DA_WRITEV
#undef DA_QK
#undef DA_SMPV
#undef DA_STEP
    unsigned char* Op = Odst + (tokbase + qpos) * 3072 + h * 128 + 4 * hh;
    const float ltot = lrun + __shfl_xor(lrun, 32);
    LAS float* X = (LAS float*)(lds + qg * 16384);
    __syncthreads();
    if (cw == 1) { const float i1 = lam * frcp(ltot);
#pragma unroll
        for (int d = 0; d < 4; ++d)
#pragma unroll
            for (int r = 0; r < 16; ++r) X[(d * 16 + r) * 64 + lane] = o[d][r] * i1; }
    __syncthreads();
    if (cw == 0) {
        const float i0 = frcp(ltot); float ss = 0.f;
#pragma unroll
        for (int d = 0; d < 4; ++d)
#pragma unroll
            for (int r = 0; r < 16; ++r) { const float y = o[d][r] * i0 - X[(d * 16 + r) * 64 + lane]; o[d][r] = y; ss += y * y; }
        ss += __shfl_xor(ss, 32);
        const float rs = frsq(ss * (1.f / 128.f) + LN_EPS) * (1.f - lam_init);
        const float* sub = I.in(5) + (size_t)L * 128 + 4 * hh;
#pragma unroll
        for (int d = 0; d < 4; ++d)
#pragma unroll
            for (int g4 = 0; g4 < 4; ++g4) { const f32x4 w = *(const f32x4*)(sub + d * 32 + 8 * g4);
                *(unsigned*)(Op + d * 32 + 8 * g4) = pack4_fp8(o[d][4 * g4] * rs * w[0], o[d][4 * g4 + 1] * rs * w[1], o[d][4 * g4 + 2] * rs * w[2], o[d][4 * g4 + 3] * rs * w[3], 8.f); }
    }
}

__device__ __forceinline__ void ln_row_store(float (&y)[4][8], const float* gam, const float* bet, float* of32, bf16* ob16, int lane, unsigned char* ob8 = nullptr) {
    float s = 0.f;
#pragma unroll
    for (int j = 0; j < 4; ++j)
#pragma unroll
        for (int i = 0; i < 8; ++i) s += y[j][i];
    const float mean = wave_sum(s) * (1.f / DM); float q = 0.f;
#pragma unroll
    for (int j = 0; j < 4; ++j)
#pragma unroll
        for (int i = 0; i < 8; ++i) { y[j][i] -= mean; q += y[j][i] * y[j][i]; }
    const float rstd = frsq(wave_sum(q) * (1.f / DM) + LN_EPS);
#pragma unroll
    for (int j = 0; j < 4; ++j) { const int e = 512 * j + 8 * lane;
        const f32x4 g0 = *(const f32x4*)(gam + e), g1 = *(const f32x4*)(gam + e + 4), b0 = *(const f32x4*)(bet + e), b1 = *(const f32x4*)(bet + e + 4);
        f32x4 o0, o1;
#pragma unroll
        for (int i = 0; i < 4; ++i) { o0[i] = y[j][i] * rstd * g0[i] + b0[i]; o1[i] = y[j][4 + i] * rstd * g1[i] + b1[i]; }
        if (of32) { *(f32x4*)(of32 + e) = o0; *(f32x4*)(of32 + e + 4) = o1; }
        *(u32x4*)(ob16 + e) = pack8(o0, o1);
        if (ob8) *(u32x2*)(ob8 + e) = pack8_fp8(o0, o1, 1.f); }
}
__device__ __forceinline__ void ln1_phase(const Ctx& C, const InRef& I, int L, int dry) {
    const bf16* YB = (const bf16*)(C.ws + WS_YB); bf16* X1B = (bf16*)(C.ws + (dry ? WS_KC : WS_X1B));
    for (int m = C.gw; m < M; m += C.NGW) {
        float y[4][8]; const bf16* row = YB + (size_t)m * DM;
#pragma unroll
        for (int j = 0; j < 4; ++j) { const u32x4 a = *(const u32x4*)(row + 512 * j + 8 * C.lane);
            y[j][0] = bflo(a.x); y[j][1] = bfhi(a.x); y[j][2] = bflo(a.y); y[j][3] = bfhi(a.y); y[j][4] = bflo(a.z); y[j][5] = bfhi(a.z); y[j][6] = bflo(a.w); y[j][7] = bfhi(a.w); }
        ln_row_store(y, I.in(16) + (size_t)L * DM, I.in(17) + (size_t)L * DM, nullptr, X1B + (size_t)m * DM, C.lane, dry ? (unsigned char*)nullptr : C.ws + WS_X1B8 + (size_t)m * DM);
    }
}

#define TOPK_INS(v_, ls) do { float v__ = (v_); _Pragma("unroll") for (int k_ = 0; k_ < 16; ++k_) { const float hi_ = fmaxf(ls[k_], v__); v__ = fminf(ls[k_], v__); ls[k_] = hi_; } } while (0)
__device__ __forceinline__ float embed_bits(float v, unsigned mask, unsigned payload) { return __builtin_bit_cast(float, (__builtin_bit_cast(unsigned, v) & ~mask) | payload); }
__device__ __forceinline__ unsigned sel16x7(unsigned p0, unsigned p1, unsigned p2, unsigned p3, unsigned i) {
    const unsigned q = i >> 2; unsigned w = p0; w = q == 1 ? p1 : w; w = q == 2 ? p2 : w; w = q == 3 ? p3 : w; return (w >> (8 * (i & 3))) & 0x7Fu;
}
__device__ __forceinline__ void ce_desc(float& a, float& b) { const float hi = fmaxf(a, b), lo = fminf(a, b); a = hi; b = lo; }
__device__ __forceinline__ void bitonic_merge16_desc(float (&v)[16]) {
#pragma unroll
    for (int j = 8; j > 0; j >>= 1)
#pragma unroll
        for (int i = 0; i < 16; ++i) if ((i & j) == 0) ce_desc(v[i], v[i | j]);
}
__device__ __forceinline__ void sort16_desc(float (&v)[16]) {
#pragma unroll
    for (int k = 2; k <= 16; k <<= 1)
#pragma unroll
        for (int j = k >> 1; j > 0; j >>= 1)
#pragma unroll
            for (int i = 0; i < 16; ++i) { const int l = i ^ j; if (l > i) { if ((i & k) == 0) ce_desc(v[i], v[l]); else ce_desc(v[l], v[i]); } }
}
__device__ __forceinline__ void top16_merge_desc(float (&a)[16], const float (&b)[16]) {
#pragma unroll
    for (int i = 0; i < 16; ++i) a[i] = fmaxf(a[i], b[15 - i]);
    bitonic_merge16_desc(a);
}
__device__ __forceinline__ void peer_select_phase(const Ctx& C) {
    const bf16* PQ = (const bf16*)(C.ws + WS_PQ); const bf16* KEYS = (const bf16*)(C.ws + WS_KEYS);
    int* SELI = (int*)(C.ws + WS_SELI); float* SELG = (float*)(C.ws + WS_SELG);
    const int lane = C.lane, qi = lane & 31, hh = lane >> 5;
    for (int wu = C.gw; wu < (M / 32) * 8; wu += C.NGW) {
        const int head = wu & 7, tg = wu >> 3, token = tg * 32 + qi;
        float s12[2][16];
#pragma unroll
        for (int p = 0; p < 2; ++p) {
            f32x16 sc[4];
#pragma unroll
            for (int kb = 0; kb < 4; ++kb) sc[kb] = (f32x16){};
            const bf16* qp = PQ + (size_t)token * 1024 + head * 128 + p * 64 + hh * 8;
            const bf16* kp = KEYS + (size_t)((head * 2 + p) * 128 + qi) * 64 + hh * 8;
#pragma unroll
            for (int ks = 0; ks < 4; ++ks) { const bf16x8 qf = *(const bf16x8*)(qp + ks * 16);
#pragma unroll
                for (int kb = 0; kb < 4; ++kb) { const bf16x8 a = *(const bf16x8*)(kp + (size_t)kb * 32 * 64 + ks * 16); sc[kb] = MFMA32(a, qf, sc[kb]); } }
            float l0[16], l1[16], l2[16], l3[16];
#pragma unroll
            for (int r = 0; r < 16; ++r) { const unsigned n = (unsigned)((r & 3) + 8 * (r >> 2) + 4 * hh);
                l0[r] = embed_bits(sc[0][r], 0x7Fu, n); l1[r] = embed_bits(sc[1][r], 0x7Fu, n + 32u); l2[r] = embed_bits(sc[2][r], 0x7Fu, n + 64u); l3[r] = embed_bits(sc[3][r], 0x7Fu, n + 96u); }
            sort16_desc(l0); sort16_desc(l1); sort16_desc(l2); sort16_desc(l3);
            top16_merge_desc(l0, l1); top16_merge_desc(l2, l3); top16_merge_desc(l0, l2);
            float ps[16];
#pragma unroll
            for (int k = 0; k < 16; ++k) ps[k] = __shfl_xor(l0[k], 32);
            top16_merge_desc(l0, ps);
#pragma unroll
            for (int k = 0; k < 16; ++k) s12[p][k] = l0[k];
        }
        unsigned P1[4], P2[4];
#pragma unroll
        for (int q = 0; q < 4; ++q) { P1[q] = 0u; P2[q] = 0u;
#pragma unroll
            for (int t = 0; t < 4; ++t) { P1[q] |= (__builtin_bit_cast(unsigned, s12[0][4 * q + t]) & 0x7Fu) << (8 * t); P2[q] |= (__builtin_bit_cast(unsigned, s12[1][4 * q + t]) & 0x7Fu) << (8 * t); } }
#define CAND(i, j) embed_bits(s12[0][i] + s12[1][j], 0xFFu, (unsigned)((i) * 16 + (j)))
        float ca[16], cb[16], cc[16], cd[16]; const float NINF = -__builtin_inff();
#pragma unroll
        for (int j = 0; j < 16; ++j) ca[j] = CAND(0, j);
#pragma unroll
        for (int j = 0; j < 8; ++j) cb[j] = CAND(1, j);
#pragma unroll
        for (int j = 0; j < 5; ++j) cb[8 + j] = CAND(2, j);
#pragma unroll
        for (int j = 0; j < 3; ++j) cb[13 + j] = CAND(4, j);
#pragma unroll
        for (int j = 0; j < 4; ++j) cc[j] = CAND(3, j);
        cc[4] = CAND(5, 0); cc[5] = CAND(5, 1); cc[6] = CAND(6, 0); cc[7] = CAND(6, 1); cc[8] = CAND(7, 0); cc[9] = CAND(7, 1);
#pragma unroll
        for (int i = 8; i < 14; ++i) cc[2 + i] = CAND(i, 0);
        cd[0] = CAND(14, 0); cd[1] = CAND(15, 0);
#pragma unroll
        for (int k = 2; k < 16; ++k) cd[k] = NINF;
#undef CAND
        sort16_desc(ca); sort16_desc(cb); sort16_desc(cc); sort16_desc(cd);
        top16_merge_desc(ca, cb); top16_merge_desc(cc, cd); top16_merge_desc(ca, cc);
        float e[16], sum = 0.f; unsigned ti[16];
#pragma unroll
        for (int k = 0; k < 16; ++k) { e[k] = fexp(ca[k] - ca[0]); sum += e[k];
            const unsigned ij = __builtin_bit_cast(unsigned, ca[k]) & 0xFFu; ti[k] = sel16x7(P1[0], P1[1], P1[2], P1[3], ij >> 4) * 128u + sel16x7(P2[0], P2[1], P2[2], P2[3], ij & 15u); }
        const float inv = frcp(sum);
        if (hh == 0) {
#pragma unroll
            for (int q = 0; q < 4; ++q) *(u32x4*)(SELI + (size_t)token * 128 + head * 16 + 4 * q) = (u32x4){ti[4 * q], ti[4 * q + 1], ti[4 * q + 2], ti[4 * q + 3]};
        } else {
#pragma unroll
            for (int q = 0; q < 4; ++q) *(f32x4*)(SELG + (size_t)token * 128 + head * 16 + 4 * q) = (f32x4){e[4 * q] * inv, e[4 * q + 1] * inv, e[4 * q + 2] * inv, e[4 * q + 3] * inv};
        }
    }
}

typedef unsigned u32x3 __attribute__((ext_vector_type(3)));
typedef unsigned u32x6 __attribute__((ext_vector_type(6)));
typedef float f32x32 __attribute__((ext_vector_type(32)));
struct __attribute__((packed, aligned(4))) U3 { unsigned a, b, c; };
__device__ __forceinline__ f32x32 dec32_fp6(const U3 w0, const U3 w1) { u32x6 w; w[0] = w0.a; w[1] = w0.b; w[2] = w0.c; w[3] = w1.a; w[4] = w1.b; w[5] = w1.c; return __builtin_amdgcn_cvt_scalef32_pk32_f32_fp6(w, 1.0f); }
__device__ __forceinline__ float dot32_fp6(const U3 w0, const U3 w1, const float (&x)[2][16]) {
    const f32x32 d = dec32_fp6(w0, w1); float a0 = 0.f, a1 = 0.f, a2 = 0.f, a3 = 0.f;
#pragma unroll
    for (int i = 0; i < 16; i += 2) { a0 += d[i] * x[0][i]; a1 += d[i + 1] * x[0][i + 1]; a2 += d[16 + i] * x[1][i]; a3 += d[17 + i] * x[1][i + 1]; }
    return (a0 + a1) + (a2 + a3);
}
#define FP4X2(d, b) __builtin_amdgcn_cvt_scalef32_pk_f32_fp4((d), 1.0f, (b))
typedef __bf16 bf16x2v __attribute__((ext_vector_type(2)));
#define FP4BF2(d, b) __builtin_amdgcn_cvt_scalef32_pk_bf16_fp4((d), 1.0f, (b))
#define DOT2BF(a, xw, c) __builtin_amdgcn_fdot2_f32_bf16((a), __builtin_bit_cast(bf16x2v, (xw)), (c), false)
typedef int i32x8 __attribute__((ext_vector_type(8)));
constexpr float XQ_SCALE = 0.5f;
struct XQ3 { u32x4 q0, q1; };
__device__ __forceinline__ i32x8 frag_fp4(const u32x4 w) { i32x8 a; a[0] = (int)w.x; a[1] = (int)w.y; a[2] = (int)w.z; a[3] = (int)w.w; a[4] = 0; a[5] = 0; a[6] = 0; a[7] = 0; return a; }
__device__ __forceinline__ float dot32_fp4(const u32x4 w, const XQ3& xq, int lane) {
    const i32x8 a = frag_fp4(w);
    f32x4 c = __builtin_amdgcn_mfma_scale_f32_16x16x128_f8f6f4(a, frag_fp4(xq.q0), (f32x4){0.f, 0.f, 0.f, 0.f}, 4, 4, 0, 0x7F7F7F7F, 0, 0x7F7F7F7F);
    c = __builtin_amdgcn_mfma_scale_f32_16x16x128_f8f6f4(a, frag_fp4(xq.q1), c, 4, 4, 0, 0x7F7F7F7F, 0, 0x7C7C7C7C);
    const float lo = (lane & 1) ? c[1] : c[0], hi = (lane & 1) ? c[3] : c[2], v = (lane & 2) ? hi : lo;
    return ((lane >> 4) == ((lane & 15) >> 2)) ? v : 0.f;
}
__device__ __forceinline__ void axpy32_fp4(const u32x4 w, float s, float (&acc)[2][16]) {
    const f32x2 ss = {s, s};
#pragma unroll
    for (int h = 0; h < 4; ++h) { const unsigned d = w[h]; const int j = h >> 1, e = 8 * (h & 1);
        const f32x2 t0 = (f32x2){acc[j][e], acc[j][e + 1]} + ss * FP4X2(d, 0), t1 = (f32x2){acc[j][e + 2], acc[j][e + 3]} + ss * FP4X2(d, 1),
                    t2 = (f32x2){acc[j][e + 4], acc[j][e + 5]} + ss * FP4X2(d, 2), t3 = (f32x2){acc[j][e + 6], acc[j][e + 7]} + ss * FP4X2(d, 3);
        acc[j][e] = t0[0]; acc[j][e + 1] = t0[1]; acc[j][e + 2] = t1[0]; acc[j][e + 3] = t1[1]; acc[j][e + 4] = t2[0]; acc[j][e + 5] = t2[1]; acc[j][e + 6] = t3[0]; acc[j][e + 7] = t3[1]; }
}
__device__ __forceinline__ void axpy32_fp6(const U3 w0, const U3 w1, float s, float (&acc)[2][16]) {
    const f32x32 d = dec32_fp6(w0, w1);
#pragma unroll
    for (int i = 0; i < 16; ++i) { acc[0][i] += s * d[i]; acc[1][i] += s * d[16 + i]; }
}
__device__ __forceinline__ void ln32_store(float (&y)[2][16], const float* gam, const float* bet, float* of32, bf16* ob16, int lane) {
    f32x4 gg[8], bb[8];
#pragma unroll
    for (int q = 0; q < 8; ++q) { const int e = 1024 * (q >> 2) + 16 * lane + 4 * (q & 3); gg[q] = *(const f32x4*)(gam + e); bb[q] = *(const f32x4*)(bet + e); }
    float s = 0.f;
#pragma unroll
    for (int j = 0; j < 2; ++j)
#pragma unroll
        for (int i = 0; i < 16; ++i) s += y[j][i];
    const float mean = wave_sum(s) * (1.f / DM); float q = 0.f;
#pragma unroll
    for (int j = 0; j < 2; ++j)
#pragma unroll
        for (int i = 0; i < 16; ++i) { y[j][i] -= mean; q += y[j][i] * y[j][i]; }
    const float rstd = frsq(wave_sum(q) * (1.f / DM) + LN_EPS);
#pragma unroll
    for (int j = 0; j < 2; ++j)
#pragma unroll
        for (int h8 = 0; h8 < 2; ++h8) { const int e = 1024 * j + 16 * lane + 8 * h8;
            const f32x4 g0 = gg[4 * j + 2 * h8], g1 = gg[4 * j + 2 * h8 + 1], b0 = bb[4 * j + 2 * h8], b1 = bb[4 * j + 2 * h8 + 1];
            f32x4 o0, o1;
#pragma unroll
            for (int i = 0; i < 4; ++i) { o0[i] = y[j][8 * h8 + i] * rstd * g0[i] + b0[i]; o1[i] = y[j][8 * h8 + 4 + i] * rstd * g1[i] + b1[i]; }
            if (of32) { *(f32x4*)(of32 + e) = o0; *(f32x4*)(of32 + e + 4) = o1; }
            if (ob16) *(u32x4*)(ob16 + e) = pack8(o0, o1); }
}
__device__ __forceinline__ void sort_picks128(int& k0, int& k1, float& g0, float& g1, int lane) {
#pragma unroll
    for (int k = 2; k <= 128; k <<= 1) {
#pragma unroll
        for (int j = k >> 1; j > 0; j >>= 1) {
            if (j == 64) { const bool sw = k0 > k1; const int tk = k0; const float tg = g0; k0 = sw ? k1 : k0; g0 = sw ? g1 : g0; k1 = sw ? tk : k1; g1 = sw ? tg : g1; }
            else {
                const bool lower = (lane & j) == 0;
                { const bool up = (lane & k) == 0; const int ok = __shfl_xor(k0, j); const float og = __shfl_xor(g0, j);
                  const bool take = (lower == up) ? (ok < k0) : (ok > k0); k0 = take ? ok : k0; g0 = take ? og : g0; }
                { const bool up = ((64 + lane) & k) == 0; const int ok = __shfl_xor(k1, j); const float og = __shfl_xor(g1, j);
                  const bool take = (lower == up) ? (ok < k1) : (ok > k1); k1 = take ? ok : k1; g1 = take ? og : g1; }
            }
        }
    }
}
__device__ __forceinline__ void sort_keys128_desc(unsigned& k0, unsigned& k1, int lane) {
#pragma unroll
    for (int k = 2; k <= 128; k <<= 1) {
#pragma unroll
        for (int j = k >> 1; j > 0; j >>= 1) {
            if (j == 64) { const bool sw = k0 < k1; const unsigned tk = k0; k0 = sw ? k1 : k0; k1 = sw ? tk : k1; }
            else {
                const bool lower = (lane & j) == 0;
                { const bool up = (lane & k) == 0; const unsigned ok = (unsigned)__shfl_xor((int)k0, j); const bool take = (lower == up) ? (ok > k0) : (ok < k0); k0 = take ? ok : k0; }
                { const bool up = ((64 + lane) & k) == 0; const unsigned ok = (unsigned)__shfl_xor((int)k1, j); const bool take = (lower == up) ? (ok > k1) : (ok < k1); k1 = take ? ok : k1; }
            }
        }
    }
}
__device__ __forceinline__ void peer_gather_phase(const Ctx& C, const InRef& I, int L, float* xout) {
    const bf16* X1B = (const bf16*)(C.ws + WS_X1B); const bf16* PLE = (const bf16*)(C.ws + WS_PW);
    const unsigned char* PU = C.ws + WS_PU; const unsigned char* PV = C.ws + WS_PV;
    const float* SU = (const float*)(C.ws + WS_SU); const float* SV = (const float*)(C.ws + WS_SV); const float* SV4 = (const float*)(C.ws + WS_SV4); const unsigned char* PV4 = C.ws + WS_PV4;
    const int* SELI = (const int*)(C.ws + WS_SELI); const float* SELG = (const float*)(C.ws + WS_SELG);
    bf16* XB = (bf16*)(C.ws + WS_XB);
    const int lane = C.lane;
    for (int m = C.gw; m < M; m += C.NGW) {
        unsigned xp[2][8];
#pragma unroll
        for (int j = 0; j < 2; ++j)
#pragma unroll
            for (int q = 0; q < 2; ++q) { const u32x4 v = *(const u32x4*)(X1B + (size_t)m * DM + 1024 * j + 16 * lane + 8 * q); xp[j][4 * q] = v.x; xp[j][4 * q + 1] = v.y; xp[j][4 * q + 2] = v.z; xp[j][4 * q + 3] = v.w; }
        XQ3 xq;
#pragma unroll
        for (int d = 0; d < 4; ++d) { unsigned w0 = 0u, w1 = 0u;
#define XQ_PAIR(bsel) { const unsigned p_ = xp[d >> 1][4 * (d & 1) + (bsel)]; const float y0 = bflo(p_) * XQ_SCALE, y1 = bfhi(p_) * XQ_SCALE; \
            w0 = __builtin_amdgcn_cvt_scalef32_pk_fp4_f32(w0, y0, y1, 1.0f, (bsel)); const f32x2 a0_ = __builtin_amdgcn_cvt_scalef32_pk_f32_fp4(w0, 1.0f, (bsel)); \
            const float r0 = (y0 - a0_[0]) * 8.f, r1 = (y1 - a0_[1]) * 8.f; \
            w1 = __builtin_amdgcn_cvt_scalef32_pk_fp4_f32(w1, r0, r1, 1.0f, (bsel)); \
            }
            XQ_PAIR(0) XQ_PAIR(1) XQ_PAIR(2) XQ_PAIR(3)
#undef XQ_PAIR
            xq.q0[d] = w0; xq.q1[d] = w1; }
        u32x4 plv[2][2];
#pragma unroll
        for (int j = 0; j < 2; ++j) { const bf16* pp = PLE + (size_t)m * DM + 1024 * j + 16 * lane; plv[j][0] = *(const u32x4*)pp; plv[j][1] = *(const u32x4*)(pp + 8); }
        float acc[2][16];
#pragma unroll
        for (int j = 0; j < 2; ++j)
#pragma unroll
            for (int i = 0; i < 16; ++i) acc[j][i] = 0.f;
        const int sk0 = SELI[(size_t)m * 128 + lane], sk1 = SELI[(size_t)m * 128 + 64 + lane]; const float sg0 = SELG[(size_t)m * 128 + lane], sg1 = SELG[(size_t)m * 128 + 64 + lane];
        float b0 = 0.f, b1 = 0.f;
#pragma unroll 1
        for (int half = 0; half < 2; ++half) {
            const int eidx = half ? sk1 : sk0; const float eg = half ? sg1 : sg0;
            const float su = SU[eidx];
            float r16[16]; u32x4 ua, ub, uc, ud, ue, uf, ug, uh; const bool b0_ = (lane & 1) != 0, b1_ = (lane & 2) != 0;
#define GU_LDX(A, k) { const int id_ = __builtin_amdgcn_readlane(eidx, (k)); A = *(const u32x4*)(PU + (size_t)id_ * P4ROW + 16 * lane); }
#define GU_DOT(A) dot32_fp4(A, xq, lane)
            GU_LDX(ua, 0) GU_LDX(ub, 1) GU_LDX(uc, 2) GU_LDX(ud, 3) GU_LDX(ue, 4) GU_LDX(uf, 5) GU_LDX(ug, 6) GU_LDX(uh, 7)
#pragma unroll
            for (int e = 0; e < 64; e += 8) {
#define GU_FOUR(A, B, C_, D, o_) { const float p0 = GU_DOT(A); if (e + (o_) + 8 < 64) GU_LDX(A, e + (o_) + 8) const float p1 = GU_DOT(B); if (e + (o_) + 9 < 64) GU_LDX(B, e + (o_) + 9) \
                const float q0 = (b0_ ? p1 : p0) + __shfl_xor(b0_ ? p0 : p1, 1); \
                const float p2 = GU_DOT(C_); if (e + (o_) + 10 < 64) GU_LDX(C_, e + (o_) + 10) const float p3 = GU_DOT(D); if (e + (o_) + 11 < 64) GU_LDX(D, e + (o_) + 11) \
                const float q1 = (b0_ ? p3 : p2) + __shfl_xor(b0_ ? p2 : p3, 1); \
                r16[(e + (o_)) >> 2] = (b1_ ? q1 : q0) + __shfl_xor(b1_ ? q0 : q1, 2); }
                GU_FOUR(ua, ub, uc, ud, 0) GU_FOUR(ue, uf, ug, uh, 4)
#undef GU_FOUR
            }
#undef GU_DOT
#undef GU_LDX
#pragma unroll
            for (int j = 2, n = 8; j < 6; ++j, n >>= 1) { const bool up = ((lane >> j) & 1) != 0;
#pragma unroll
                for (int k = 0; k < n; ++k) { const float a = r16[2 * k], b = r16[2 * k + 1]; r16[k] = (up ? b : a) + __shfl_xor(up ? a : b, 1 << j); } }
            const float dot = r16[0] * su * (1.f / XQ_SCALE);
            const float act = pg8::gelu_pk((f32x2){dot, dot})[0];
            b0 = half ? b0 : eg * act; b1 = half ? eg * act : b1;
        }
        const int ri0 = sk0, ri1 = sk1; const float w0 = b0 * SV4[sk0], w1 = b1 * SV4[sk1];
        { u32x4 va, vb, vc, vd, ve, vf, vg, vh;
#define GB_LDX(RI, A, k) { const int id_ = __builtin_amdgcn_readlane(RI, (k)); A = *(const u32x4*)(PV4 + (size_t)id_ * P4ROW + 16 * lane); }
#define GB_AX(WW, A, k) { const float w_ = __builtin_bit_cast(float, __builtin_amdgcn_readlane(__builtin_bit_cast(int, WW), (k))); axpy32_fp4(A, w_, acc); }
#define GB_STEP(RI, WW, HI, A, o_) GB_AX(WW, A, e + (o_)) GB_LDX(RI, A, e + (o_) + 8 < (HI) - 1 ? e + (o_) + 8 : (HI) - 1)
#define GB_LOOP(RI, WW, LO, HI) { GB_LDX(RI, va, (LO)) GB_LDX(RI, vb, (LO) + 1) GB_LDX(RI, vc, (LO) + 2) GB_LDX(RI, vd, (LO) + 3) GB_LDX(RI, ve, (LO) + 4) GB_LDX(RI, vf, (LO) + 5) GB_LDX(RI, vg, (LO) + 6) GB_LDX(RI, vh, (LO) + 7) \
            _Pragma("unroll 1") for (int e = (LO); e < (HI); e += 8) { GB_STEP(RI, WW, HI, va, 0) GB_STEP(RI, WW, HI, vb, 1) GB_STEP(RI, WW, HI, vc, 2) GB_STEP(RI, WW, HI, vd, 3) GB_STEP(RI, WW, HI, ve, 4) GB_STEP(RI, WW, HI, vf, 5) GB_STEP(RI, WW, HI, vg, 6) GB_STEP(RI, WW, HI, vh, 7) } }
            GB_LOOP(ri0, w0, 0, 64)
            GB_LOOP(ri1, w1, 0, 64)
#undef GB_LOOP
#undef GB_STEP
#undef GB_LDX
#undef GB_AX
        }
#pragma unroll
        for (int j = 0; j < 2; ++j) { const u32x4 p0 = plv[j][0], p1 = plv[j][1];
            const float pl[16] = {bflo(p0.x), bfhi(p0.x), bflo(p0.y), bfhi(p0.y), bflo(p0.z), bfhi(p0.z), bflo(p0.w), bfhi(p0.w), bflo(p1.x), bfhi(p1.x), bflo(p1.y), bfhi(p1.y), bflo(p1.z), bfhi(p1.z), bflo(p1.w), bfhi(p1.w)};
#pragma unroll
            for (int i = 0; i < 16; ++i) acc[j][i] += ALPHA * ((i & 1) ? bfhi(xp[j][i >> 1]) : bflo(xp[j][i >> 1])) + pl[i]; }
        ln32_store(acc, I.in(25) + (size_t)L * DM, I.in(26) + (size_t)L * DM, xout ? xout + (size_t)m * DM : (float*)nullptr, xout ? (bf16*)nullptr : XB + (size_t)m * DM, lane);
    }
}

struct Args { InPtrs I; float* out; unsigned char* ws; int ph_lo, ph_hi, dry, pad; };
constexpr int PH_PER_LAYER = 10, N_PHASES = DEPTH * PH_PER_LAYER;

__global__ void __launch_bounds__(NTHR, 2) mk_fwd(Args args) {
    extern __shared__ __attribute__((aligned(16))) unsigned char lds_raw[];
    Ctx C;
    C.lds = (LAS unsigned char*)lds_raw; C.ws = (unsigned char*)(GAS unsigned char*)args.ws; C.ctl = (gu32*)(C.ws + WS_CTL);
    C.tid = threadIdx.x; C.lane = C.tid & 63; C.wave = __builtin_amdgcn_readfirstlane(C.tid >> 6);
    C.G = gridDim.x; C.bid = blockIdx.x; C.gw = blockIdx.x * NWAVES + C.wave; C.NGW = C.G * NWAVES;
    volatile LAS unsigned* MISC = (volatile LAS unsigned*)(C.lds + MISC_OFF);
    for (int u = C.tid; u < (LDS_BYTES - 131072) / 4; u += NTHR) ((LAS unsigned*)(C.lds + 131072))[u] = 0u;
    __syncthreads();
    XcdBarrier bar = xcd_barrier_post((unsigned*)(C.ctl + CW_BAR), MISC + 8);
    const int lo = args.ph_lo, hi = args.ph_hi;
    LAS unsigned char* ring = C.lds;

    for (int L = 0; L < DEPTH; ++L) {
        const int pb = L * PH_PER_LAYER;
#ifndef PHMASK
#define PHMASK 0x3ff
#endif
#define IN(k) (((PHMASK >> (k)) & 1) && lo <= pb + (k) && pb + (k) < hi)
#define SEAM(k) do { if (pb + (k) + 1 < hi) xcd_barrier(bar); } while (0)
#define XRES() ((L == 0) ? I.in(0) : (const float*)nullptr)
#define B_IN() (I.in(3) + (size_t)L * IN_TOTAL)

        if (IN(0)) { const Ctx P = fresh_ctx(C); const InRef I = fresh_in(); prologue_phase(P, I, L, XRES()); SEAM(0); }

        if (IN(1)) { const Ctx P = fresh_ctx(C); const InRef I = fresh_in(); const float* b_in = B_IN();
            if (P.bid < 16 && P.wave == 0) cumsum_seq(P, P.bid);
            __syncthreads();
#ifndef SUBMASK
#define SUBMASK 7
#endif
            if (SUBMASK & 1) { pg8::Gemm g{(const bf16*)(P.ws + WS_XB8), (const bf16*)(P.ws + WS_WIN), M, NIN, DM / 2, 0, 0}; pg8::StaticOrder S; S.init(M, NIN, P.G, P.bid);
              EpiInProj E{P.ws, b_in, 0};
              pg8::gemm_phase<EpiInProj, pg8::StaticOrder, true, true, true>(ring, g, S, E); }
            if (SUBMASK & 2) { pg8::Gemm g{(const bf16*)(P.ws + WS_WV), (const bf16*)(P.ws + WS_XB8), 2048, M, DM / 2, 0, 0}; pg8::StaticOrder S; S.init(2048, M, P.G, P.bid);
              EpiVT E{(bf16*)(P.ws + WS_VT), b_in};
              pg8::gemm_phase<EpiVT, pg8::StaticOrder, true, true, true, 0x7F, 0x79>(ring, g, S, E); }
            SEAM(1);
        }

        if (IN(2)) {
            for (int u = blockIdx.x; u < BATCH * LRU_NCH * 8; u += C.G) { const Ctx P = fresh_ctx(C); const InRef I = fresh_in(); lru_unit<false>(P, I, L, u, nullptr); }
            { const Ctx P = fresh_ctx(C); kmax_phase(P, L); }
            SEAM(2);
        }

        if (IN(3)) {
#ifndef PROBE_SUB
#define PROBE_SUB 7
#endif
            const int dry = args.dry; const int subm = dry ? PROBE_SUB : 7; gu32* qh = C.ctl + CW_QUEUE + 64 * (L * 3) + (dry ? 64 * 8 : 0);
            if (subm & 1) { const int myx = (int)(bar.x & 7u); gu32* qx = C.ctl + CW_QUEUE + 2048 + 1024 * L + (dry ? 512 : 0);
              for (int qq = 0; qq < 8; ++qq) { const int xq = (myx + qq) & 7;
                for (;;) { __syncthreads(); if (C.tid == 0) MISC[16] = __hip_atomic_fetch_add(qx + 64 * xq, 1u, RLX_AGENT); __syncthreads();
                    const int idx = (int)MISC[16]; if (idx >= 128) break;
                    const int qb = 63 - (idx >> 1), bh = 2 * xq + (idx & 1); const Ctx P = fresh_ctx(C); const InRef I = fresh_in(); attn_diff_unit(P, I, L, bh >> 3, bh & 7, qb, P.ws + WS_Y3); } } }
            if (subm & 2) for (;;) { __syncthreads(); if (C.tid == 0) MISC[16] = __hip_atomic_fetch_add(qh + 64, 1u, RLX_AGENT); __syncthreads();
                const int idx = (int)MISC[16]; if (idx >= 512) break;
                const int qb = 31 - (idx >> 4), bh = idx & 15; const Ctx P = fresh_ctx(C); const InRef I = fresh_in(); attn_unit<1>(P, I, L, bh >> 3, bh & 7, qb, P.ws + WS_Y3 + 2048); }
            if (subm & 4) for (;;) { __syncthreads(); if (C.tid == 0) MISC[16] = __hip_atomic_fetch_add(qh + 128, 1u, RLX_AGENT); __syncthreads();
                const int idx = (int)MISC[16]; if (idx >= BATCH * LRU_NCH * 8) break;
                const Ctx P = fresh_ctx(C); const InRef I = fresh_in(); lru_final_unit(P, idx, P.ws + WS_Y3 + 1024); }
            SEAM(3);
        }

        if (IN(4)) { const Ctx P = fresh_ctx(C);
            pg8::Gemm g{(const bf16*)(P.ws + WS_Y3), (const bf16*)(P.ws + WS_WBR), M, DM, 1536, 0, 0}; pg8::StaticOrder S; S.init(M, DM, P.G, P.bid);
            EpiMerge E{(const bf16*)(P.ws + WS_G), (bf16*)(P.ws + WS_X1B)};
            pg8::gemm_phase<EpiMerge, pg8::StaticOrder, true, true, true, 0x79, 0x7C>(ring, g, S, E);
            SEAM(4);
        }

        if (IN(5)) { const Ctx P = fresh_ctx(C); const InRef I = fresh_in(); const bf16* xres = (const bf16*)(P.ws + WS_XB);
            if (SUBMASK & 1) { pg8::Gemm g{(const bf16*)(P.ws + WS_PB), (const bf16*)(P.ws + WS_WPLE), M, DM, 256, 0, 0}; pg8::StaticOrder S; S.init(M, DM, P.G, P.bid);
              EpiPlain E{(bf16*)(P.ws + WS_PW), DM};
              pg8::gemm_phase<EpiPlain, pg8::StaticOrder, true, true>(ring, g, S, E); }
            if (SUBMASK & 2) { pg8::Gemm g{(const bf16*)(P.ws + WS_X1B), (const bf16*)(P.ws + WS_WO), M, DM, DM / 2, 0, 0}; pg8::StaticOrder S; S.init(M, DM, P.G, P.bid);
              EpiWo E{xres, (bf16*)(P.ws + WS_YB)};
              pg8::gemm_phase<EpiWo, pg8::StaticOrder, true, true, true, 0x79, 0x7C>(ring, g, S, E); }
            SEAM(5);
        }

        if (IN(6)) { const Ctx P = fresh_ctx(C); const InRef I = fresh_in(); ln1_phase(P, I, L, args.dry); SEAM(6); }

        if (IN(7)) { const Ctx P = fresh_ctx(C); const InRef I = fresh_in();
            { pg8::Gemm g{(const bf16*)(P.ws + WS_X1B8), (const bf16*)(P.ws + WS_WPGQ), M, 2048, DM / 2, 0, 0}; pg8::StaticOrder S; S.init(M, 2048, P.G, P.bid);
              EpiPgq E{(bf16*)(P.ws + WS_PW), (bf16*)(P.ws + WS_PQ), I.in(24) + (size_t)L * DM, (bf16*)(P.ws + WS_PW), 0};
              pg8::gemm_phase<EpiPgq, pg8::StaticOrder, true, true, true>(ring, g, S, E); }
            { pg8::Gemm g{(const bf16*)(P.ws + WS_X1B), (const bf16*)(P.ws + WS_WPGQ) + (size_t)2048 * DM, M, 1024, DM, 0, 0}; pg8::StaticOrder S; S.init(M, 1024, P.G, P.bid);
              EpiPgq E{(bf16*)(P.ws + WS_PW), (bf16*)(P.ws + WS_PQ), I.in(24) + (size_t)L * DM, (bf16*)(P.ws + WS_PW), 8};
              pg8::gemm_phase<EpiPgq, pg8::StaticOrder, true, true>(ring, g, S, E); }
            SEAM(7);
        }

        if (IN(8)) { const Ctx P = fresh_ctx(C); peer_select_phase(P); SEAM(8); }

        if (IN(9)) { const Ctx P = fresh_ctx(C); const InRef I = fresh_in(); peer_gather_phase(P, I, L, L == DEPTH - 1 ? (float*)(GAS float*)args.out : (float*)nullptr); SEAM(9); }
#undef IN
#undef SEAM
    }
}

extern "C" void kernel_launch(void* const* d_in, const int* in_sizes, int n_in, void* d_out, int out_size, void* d_ws, size_t ws_size, hipStream_t stream) {
    static int grid = 0;
    if (grid == 0) {
        if (n_in != 27 || in_sizes[0] != M * DM || out_size != M * DM || ws_size < WS_END) {
            fprintf(stderr, "kernel_launch: unexpected shapes (n_in %d, in0 %d, out %d, ws %zu); nothing launched\n", n_in, n_in > 0 ? in_sizes[0] : -1, out_size, ws_size); grid = -1; return; }
        int dev = 0, cus = 0, per_cu = 0;
        if (hipGetDevice(&dev) != hipSuccess || hipDeviceGetAttribute(&cus, hipDeviceAttributeMultiprocessorCount, dev) != hipSuccess) { grid = -1; return; }
        if (hipFuncSetAttribute((const void*)mk_fwd, hipFuncAttributeMaxDynamicSharedMemorySize, LDS_BYTES) != hipSuccess) { fprintf(stderr, "kernel_launch: hipFuncSetAttribute failed\n"); grid = -1; return; }
        if (hipOccupancyMaxActiveBlocksPerMultiprocessor(&per_cu, (const void*)mk_fwd, NTHR, LDS_BYTES) != hipSuccess || per_cu < 1) { fprintf(stderr, "kernel_launch: occupancy query reports %d\n", per_cu); }
        (void)hipGetLastError();
        grid = cus;
    }
    if (grid < 0) return;
    if (hipMemsetAsync((char*)d_ws + WS_CTL, 0, CTL_ZERO_BYTES, stream) != hipSuccess) return;
    Args a{};
    for (int i = 0; i < 27; ++i) a.I.in[i] = (const float*)d_in[i];
    a.out = (float*)d_out; a.ws = (unsigned char*)d_ws;
#if MK_MULTI
#ifndef PROBE_MASK
#define PROBE_MASK 0
#endif
    for (int p = 0; p < N_PHASES; ++p) { a.ph_lo = p; a.ph_hi = p + 1;
        if ((PROBE_MASK >> (p % PH_PER_LAYER)) & 1) { a.dry = 1; hipLaunchKernelGGL(mk_fwd, dim3(grid), dim3(NTHR), LDS_BYTES, stream, a); }
        a.dry = 0; hipLaunchKernelGGL(mk_fwd, dim3(grid), dim3(NTHR), LDS_BYTES, stream, a); }
#else
    a.ph_lo = 0; a.ph_hi = N_PHASES; a.dry = 0;
    hipLaunchKernelGGL(mk_fwd, dim3(grid), dim3(NTHR), LDS_BYTES, stream, a);
#endif
    const hipError_t le = hipPeekAtLastError();
    if (le != hipSuccess) fprintf(stderr, "kernel_launch: launch failed: %s\n", hipGetErrorName(le));
}
```

```cpp
#include <hip/hip_runtime.h>
#include <cstdio>
#include <cstdint>
namespace pg8 {
#define PG8_LAS __attribute__((address_space(3)))
typedef unsigned short bf16_t;
typedef short bf16x8 __attribute__((ext_vector_type(8)));
typedef float f32x4 __attribute__((ext_vector_type(4)));
typedef unsigned u32x4 __attribute__((ext_vector_type(4)));
constexpr int BM = 256, BK = 64, HALF = 128, HTB = HALF * BK * 2  , STAGE_BYTES = 8 * HTB, NXCD = 8, WGM = 4;

__host__ __device__ __forceinline__ int lds_byte(int r, int c) { const int st = (r >> 4) * 2 + (c >> 5), rr = r & 15, cc = c & 31, ob = rr * 64 + cc * 2; return st * 1024 + (ob ^ (((ob >> 9) & 1) << 5)); }
__host__ __device__ __forceinline__ void stage_rc(int b, int& R, int& C) { const int st = b / 1024, sb = b % 1024, swz = sb ^ (((sb >> 9) & 1) << 5); R = (st >> 1) * 16 + swz / 64; C = (st & 1) * 32 + (swz % 64) / 2; }
__host__ __device__ __forceinline__ int perm32(int rho) { const int n = rho >> 4, i = rho & 15; return 8 * (i >> 2) + 4 * n + (i & 3); }

struct Unit { int pm, pn, z; };
struct Gemm { const bf16_t* A; const bf16_t* Bt; int M, N, K; size_t zA, zB; };

struct StaticOrder {
    int nM, nN, nwg, G, c;
    __host__ __device__ void init(int M, int N, int G_, int c_) { nM = M / BM; nN = N / BM; nwg = nM * nN; G = G_; c = c_; }
    __host__ __device__ bool next(int i, Unit& u) const {
        const long L = (long)i * G + c; if (L >= nwg) return false;
        int wgid = (int)L; { const int q = nwg / NXCD, r = nwg % NXCD, xcd = wgid % NXCD, off = wgid / NXCD; wgid = (xcd < r ? xcd * (q + 1) : r * (q + 1) + (xcd - r) * q) + off; }
        const int nig = WGM * nN, gid = wgid / nig, fm = gid * WGM, gsz = (nM - fm) < WGM ? (nM - fm) : WGM;
        u.pm = fm + ((wgid % nig) % gsz); u.pn = (wgid % nig) / gsz; u.z = 0; return true;
    }
    __device__ __forceinline__ void a_ready(const Unit&) const {}
    __device__ __forceinline__ void done(const Unit&) const {}
};

__device__ __forceinline__ unsigned cvt_pk_bf16(float lo, float hi) { unsigned r; asm volatile("v_cvt_pk_bf16_f32 %0, %1, %2" : "=v"(r) : "v"(lo), "v"(hi)); return r; }
typedef float f32x2 __attribute__((ext_vector_type(2)));
__device__ __forceinline__ f32x2 gelu_pk(f32x2 v) {
    const f32x2 av = __builtin_elementwise_abs(v), d = av * 0.2316418882f + 1.0f;
    f32x2 t; t.x = __builtin_amdgcn_rcpf(d.x); t.y = __builtin_amdgcn_rcpf(d.y);
    f32x2 q = t * 0.5307027145f + (-0.7265760135f); q = q * t + 0.7107068705f; q = q * t + (-0.142248368f); q = q * t + 0.127414796f; q = q * t;
    const f32x2 s = (v * v) * (-0.72134752044f);
    f32x2 e; e.x = __builtin_amdgcn_exp2f(s.x); e.y = __builtin_amdgcn_exp2f(s.y);
    const f32x2 m = v * (q * e), r = v - m;
    f32x2 o; o.x = v.x < 0.f ? m.x : r.x; o.y = v.y < 0.f ? m.y : r.y; return o;
}


typedef int pg8_i32x8 __attribute__((ext_vector_type(8)));
typedef short pg8_bf16x16 __attribute__((ext_vector_type(16)));
typedef int pg8_i32x4 __attribute__((ext_vector_type(4)));
template <bool FP8>
__device__ __forceinline__ f32x4 mma_tile(const bf16x8 b0, const bf16x8 b1, const bf16x8 a0, const bf16x8 a1, f32x4 c) {
    if constexpr (FP8) { const pg8_i32x4 bl = __builtin_bit_cast(pg8_i32x4, b0), bh = __builtin_bit_cast(pg8_i32x4, b1), al = __builtin_bit_cast(pg8_i32x4, a0), ah = __builtin_bit_cast(pg8_i32x4, a1);
        pg8_i32x8 B_, A_; B_[0] = bl[0]; B_[1] = bl[1]; B_[2] = bl[2]; B_[3] = bl[3]; B_[4] = bh[0]; B_[5] = bh[1]; B_[6] = bh[2]; B_[7] = bh[3];
        A_[0] = al[0]; A_[1] = al[1]; A_[2] = al[2]; A_[3] = al[3]; A_[4] = ah[0]; A_[5] = ah[1]; A_[6] = ah[2]; A_[7] = ah[3];
        return __builtin_amdgcn_mfma_scale_f32_16x16x128_f8f6f4(B_, A_, c, 0, 0, 0, 0x79797979, 0, 0x7F7F7F7F); }
    else { c = __builtin_amdgcn_mfma_f32_16x16x32_bf16(b0, a0, c, 0, 0, 0); return __builtin_amdgcn_mfma_f32_16x16x32_bf16(b1, a1, c, 0, 0, 0); }
}
template <class Epi, class Sched, bool ALIGN_EPI = false, bool SP2 = false, bool FP8 = false, int SCB = 0x79, int SCA = 0x7F>
__device__ __forceinline__ void gemm_phase(PG8_LAS unsigned char* lds, const Gemm g, const Sched& S, const Epi& E) {
    int tid = threadIdx.x; asm volatile("" : "+v"(tid));
    const int wid = __builtin_amdgcn_readfirstlane(tid >> 6), lane = tid & 63, wr = wid >> 2, wc = wid & 3, fr = lane & 15, fq = lane >> 4;
    int K = g.K; asm volatile("" : "+s"(K)); const int nt = K / BK;
    unsigned voffA[2], voffB[2];
#pragma unroll
    for (int i = 0; i < 2; ++i) { int R, C; stage_rc(tid * 16 + i * 8192, R, C); const int Rb = Epi::PERM ? ((R & ~31) + perm32(R & 31)) : R;
        voffA[i] = (unsigned)(R * K + C) * 2u; voffB[i] = (unsigned)(Rb * K + C) * 2u; }
    const size_t kstep = (size_t)(BK * 2);
    const size_t hstep = (size_t)HALF * K * 2;
    const size_t tstep = 2 * hstep;
    const unsigned ldsw = (unsigned)wid * 1024u;
    const int aoff = lds_byte(wr * 64 + fr, fq * 8), boff = lds_byte(wc * 32 + fr, fq * 8);
#define PG8_SA(b, h) (((b) * 2 + (h)) * HTB)
#define PG8_SB(b, h) ((4 + (b) * 2 + (h)) * HTB)
#define PG8_STAGE(bufoff, gbase, voff) do { _Pragma("unroll") for (int _i = 0; _i < 2; ++_i) \
        __builtin_amdgcn_global_load_lds((const unsigned*)((const char*)(gbase) + (voff)[_i]), (PG8_LAS unsigned*)(lds + (bufoff) + ldsw + _i * 8192), 16, 0, 0); } while (0)
#define PG8_CAT(p_) __builtin_shufflevector(*(const PG8_LAS bf16x8*)(p_), *(const PG8_LAS bf16x8*)((p_) + 1024), 0, 1, 2, 3, 4, 5, 6, 7, 8, 9, 10, 11, 12, 13, 14, 15)
#define PG8_LDA(dst, b, h) do { if constexpr (FP8) { _Pragma("unroll") for (int m = 0; m < 4; ++m) dst##8[m] = PG8_CAT(lds + PG8_SA(b, h) + aoff + m * 2048); } \
        else { _Pragma("unroll") for (int m = 0; m < 4; ++m) _Pragma("unroll") for (int k = 0; k < 2; ++k) dst[m][k] = *(const PG8_LAS bf16x8*)(lds + PG8_SA(b, h) + aoff + m * 2048 + k * 1024); } } while (0)
#define PG8_LDB(dst, b, h) do { if constexpr (FP8) { _Pragma("unroll") for (int n = 0; n < 2; ++n) dst##8[n] = PG8_CAT(lds + PG8_SB(b, h) + boff + n * 2048); } \
        else { _Pragma("unroll") for (int n = 0; n < 2; ++n) _Pragma("unroll") for (int k = 0; k < 2; ++k) dst[n][k] = *(const PG8_LAS bf16x8*)(lds + PG8_SB(b, h) + boff + n * 2048 + k * 1024); } } while (0)
#define PG8_MMA(ai, bj, At, Bt) do { __builtin_amdgcn_s_setprio(1); _Pragma("unroll") for (int m = 0; m < 4; ++m) _Pragma("unroll") for (int n = 0; n < 2; ++n) { \
        if constexpr (FP8) asm("v_mfma_scale_f32_16x16x128_f8f6f4 %0, %1, %2, %0, %3, %4 op_sel_hi:[0,0,0]" : "+v"(acc[ai][bj][m][n]) : "v"(Bt##8[n]), "v"(At##8[m]), "v"(sc_w), "v"(sc_x));     \
        else acc[ai][bj][m][n] = mma_tile<false>(Bt[n][0], Bt[n][1], At[m][0], At[m][1], acc[ai][bj][m][n]); } __builtin_amdgcn_s_setprio(0); } while (0)
#define PG8_WAIT_V(n) asm volatile("s_waitcnt vmcnt(" #n ")" ::: "memory")
#define PG8_WAIT_L(n) asm volatile("s_waitcnt lgkmcnt(" #n ")" ::: "memory")
#define PG8_BAR __builtin_amdgcn_s_barrier()
#define PG8_SCHED __builtin_amdgcn_sched_barrier(0)
    Unit cur, nxt; int ui = 0;
    if (!S.next(0, cur)) return;
    f32x4 acc[2][2][4][2];
#pragma unroll
    for (int a = 0; a < 2; ++a)
#pragma unroll
        for (int b = 0; b < 2; ++b)
#pragma unroll
            for (int m = 0; m < 4; ++m)
#pragma unroll
                for (int n = 0; n < 2; ++n) acc[a][b][m][n] = (f32x4){0.f, 0.f, 0.f, 0.f};
    bf16x8 At[4][2], B0[2][2], B1[2][2];
    const int sc_w = SCB * 0x01010101, sc_x = SCA * 0x01010101;
    pg8_bf16x16 At8[4], B08[2], B18[2];
    const char* cA = (const char*)g.A + (size_t)cur.pm * tstep + (size_t)cur.z * g.zA; const char* cB = (const char*)g.Bt + (size_t)cur.pn * tstep + (size_t)cur.z * g.zB;
    S.a_ready(cur);
    if constexpr (SP2) {
        PG8_STAGE(PG8_SB(0, 0), cB, voffB); PG8_STAGE(PG8_SB(0, 1), cB + hstep, voffB); PG8_STAGE(PG8_SA(0, 0), cA, voffA); PG8_STAGE(PG8_SA(0, 1), cA + hstep, voffA);
        if (wr == 1) PG8_BAR;
        PG8_WAIT_V(2); PG8_BAR;
        PG8_STAGE(PG8_SB(1, 0), cB + kstep, voffB); PG8_STAGE(PG8_SA(1, 0), cA + kstep, voffA); PG8_STAGE(PG8_SB(1, 1), cB + hstep + kstep, voffB);
        PG8_WAIT_V(6); PG8_BAR;
    } else {
        PG8_STAGE(PG8_SB(0, 0), cB, voffB); PG8_STAGE(PG8_SA(0, 0), cA, voffA); PG8_STAGE(PG8_SB(0, 1), cB + hstep, voffB); PG8_STAGE(PG8_SA(0, 1), cA + hstep, voffA);
        if (wr == 1) PG8_BAR;
        PG8_WAIT_V(4); PG8_BAR;
        PG8_STAGE(PG8_SB(1, 0), cB + kstep, voffB); PG8_STAGE(PG8_SA(1, 0), cA + kstep, voffA); PG8_STAGE(PG8_SB(1, 1), cB + hstep + kstep, voffB);
        PG8_WAIT_V(6); PG8_BAR;
    }
    for (;;) {
        const bool has_next = S.next(ui + 1, nxt);
        const char* nA = has_next ? (const char*)g.A + (size_t)nxt.pm * tstep + (size_t)nxt.z * g.zA : cA; const char* nB = has_next ? (const char*)g.Bt + (size_t)nxt.pn * tstep + (size_t)nxt.z * g.zB : cB;
        for (int t = 0; t < nt; t += 2) {
            if constexpr (Epi::HOOK) { if (t == Epi::HOOK_T0 || t == Epi::HOOK_T1) E.hook(acc, cur, t, wr, wc, fr, fq); }
            const bool last = (t == nt - 2);
            const char* a1 = cA + (size_t)(t + 1) * kstep;
            const char* a2 = last ? nA : cA + (size_t)(t + 2) * kstep; const char* b2 = last ? nB : cB + (size_t)(t + 2) * kstep;
            const char* a3 = a2 + kstep; const char* b3 = b2 + kstep;
            if (last && has_next) S.a_ready(nxt);
            if constexpr (SP2) {
            PG8_LDB(B0, 0, 0); PG8_LDB(B1, 0, 1); PG8_SCHED; PG8_LDA(At, 0, 0); PG8_STAGE(PG8_SA(1, 1), a1 + hstep, voffA);
            PG8_WAIT_V(8); PG8_WAIT_L(0); PG8_BAR; PG8_MMA(0, 0, At, B0); PG8_MMA(0, 1, At, B1); PG8_BAR; PG8_SCHED;
            PG8_LDA(At, 0, 1); PG8_STAGE(PG8_SB(0, 0), b2, voffB); PG8_STAGE(PG8_SB(0, 1), b2 + hstep, voffB); PG8_STAGE(PG8_SA(0, 0), a2, voffA);
            PG8_WAIT_V(8); PG8_WAIT_L(0); PG8_BAR; PG8_MMA(1, 0, At, B0); PG8_MMA(1, 1, At, B1); PG8_BAR; PG8_SCHED;
            PG8_LDB(B0, 1, 0); PG8_LDB(B1, 1, 1); PG8_SCHED; PG8_LDA(At, 1, 0); PG8_STAGE(PG8_SA(0, 1), a2 + hstep, voffA);
            PG8_WAIT_V(8); PG8_WAIT_L(0); PG8_BAR; PG8_MMA(0, 0, At, B0); PG8_MMA(0, 1, At, B1); PG8_BAR; PG8_SCHED;
            PG8_LDA(At, 1, 1); PG8_STAGE(PG8_SB(1, 0), b3, voffB); PG8_STAGE(PG8_SB(1, 1), b3 + hstep, voffB); PG8_STAGE(PG8_SA(1, 0), a3, voffA);
            PG8_WAIT_V(8); PG8_WAIT_L(0); PG8_BAR; PG8_MMA(1, 0, At, B0); PG8_MMA(1, 1, At, B1); PG8_BAR; PG8_SCHED;
            } else {
            PG8_LDB(B0, 0, 0); PG8_SCHED; PG8_LDA(At, 0, 0); PG8_STAGE(PG8_SA(1, 1), a1 + hstep, voffA);
            PG8_WAIT_L(8); PG8_BAR; PG8_WAIT_L(0); PG8_MMA(0, 0, At, B0); PG8_BAR; PG8_SCHED;
            PG8_LDB(B1, 0, 1); PG8_STAGE(PG8_SB(0, 0), b2, voffB);
            PG8_BAR; PG8_WAIT_L(0); PG8_MMA(0, 1, At, B1); PG8_BAR;
            PG8_LDA(At, 0, 1); PG8_STAGE(PG8_SA(0, 0), a2, voffA);
            PG8_BAR; PG8_WAIT_L(0); PG8_MMA(1, 0, At, B0); PG8_BAR; PG8_SCHED;
            PG8_STAGE(PG8_SB(0, 1), b2 + hstep, voffB);
            PG8_WAIT_V(6); PG8_BAR; PG8_MMA(1, 1, At, B1); PG8_BAR;
            PG8_LDB(B0, 1, 0); PG8_SCHED; PG8_LDA(At, 1, 0); PG8_STAGE(PG8_SA(0, 1), a2 + hstep, voffA);
            PG8_WAIT_L(8); PG8_BAR; PG8_WAIT_L(0); PG8_MMA(0, 0, At, B0); PG8_BAR; PG8_SCHED;
            PG8_LDB(B1, 1, 1); PG8_STAGE(PG8_SB(1, 0), b3, voffB);
            PG8_BAR; PG8_WAIT_L(0); PG8_MMA(0, 1, At, B1); PG8_BAR;
            PG8_LDA(At, 1, 1); PG8_STAGE(PG8_SA(1, 0), a3, voffA);
            PG8_BAR; PG8_WAIT_L(0); PG8_MMA(1, 0, At, B0); PG8_BAR; PG8_SCHED;
            PG8_STAGE(PG8_SB(1, 1), b3 + hstep, voffB);
            PG8_WAIT_V(6); PG8_BAR; PG8_MMA(1, 1, At, B1); PG8_BAR;
            }
        }
        if constexpr (ALIGN_EPI) { if (wr == 0) PG8_BAR; }
        if constexpr (!Epi::AFTER_DRAIN) { E(acc, cur, wr, wc, fr, fq); S.done(cur); }
        if (!has_next) break;
#pragma unroll
        for (int a = 0; a < 2; ++a)
#pragma unroll
            for (int b = 0; b < 2; ++b)
#pragma unroll
                for (int m = 0; m < 4; ++m)
#pragma unroll
                    for (int n = 0; n < 2; ++n) acc[a][b][m][n] = (f32x4){0.f, 0.f, 0.f, 0.f};
        cur = nxt; cA = nA; cB = nB; ++ui;
        if constexpr (ALIGN_EPI) { if (wr == 1) PG8_BAR; }
    }
    PG8_WAIT_V(0);
    if constexpr (!ALIGN_EPI) { if (wr == 0) PG8_BAR; }
    PG8_BAR;
    if constexpr (Epi::AFTER_DRAIN) { E.fused(acc, cur, wr, wc, fr, fq, lds, wid, lane); S.done(cur); }
#undef PG8_SA
#undef PG8_SB
#undef PG8_STAGE
#undef PG8_LDA
#undef PG8_LDB
#undef PG8_MMA
#undef PG8_WAIT_V
#undef PG8_WAIT_L
#undef PG8_BAR
#undef PG8_SCHED
}
}

#define GAS __attribute__((address_space(1)))
#define LAS __attribute__((address_space(3)))
typedef unsigned short bf16;
typedef short bf16x8 __attribute__((ext_vector_type(8)));
typedef float f32x4 __attribute__((ext_vector_type(4)));
typedef float f32x2 __attribute__((ext_vector_type(2)));
typedef float f32x16 __attribute__((ext_vector_type(16)));
typedef unsigned u32x4 __attribute__((ext_vector_type(4)));
typedef unsigned u32x2 __attribute__((ext_vector_type(2)));
typedef __bf16 bf16x2_t __attribute__((ext_vector_type(2)));
typedef GAS unsigned gu32;

#ifndef MK_MULTI
#define MK_MULTI 0
#endif

constexpr int NWAVES = 8, NTHR = 512;
constexpr int BATCH = 2, SEQ = 8192, DM = 2048, M = BATCH * SEQ, DEPTH = 2;
constexpr int IN_TOTAL = 14344, COL_FC = 8192, COL_GATE = 8200;
constexpr int NIN = 12288;
constexpr int NEXP = 16384;
constexpr float LN_EPS = 1e-5f;
constexpr float ALPHA = 1.4142135623730951f;
constexpr float LOG2E = 1.4426950408889634f;
constexpr float SCALE_A = 0.125f * LOG2E;
constexpr float SCALE_C = 0.08838834764831845f * LOG2E;
constexpr int LRU_TC = 64, LRU_NCH = SEQ / LRU_TC;

constexpr size_t MiB = 1u << 20;
constexpr size_t WS_CTL = 0, CTL_ZERO_BYTES = 1 * MiB;
constexpr size_t WS_LOGF = 1 * MiB;
constexpr size_t WS_CUM2 = 1 * MiB + 512 * 1024;
constexpr size_t WS_LSUM = 2 * MiB;
constexpr size_t WS_WLA = 4 * MiB;
constexpr size_t WS_WLX = 4 * MiB + 256 * 1024;
constexpr size_t WS_KEYS = 4 * MiB + 512 * 1024;
constexpr size_t WS_SELI = 8 * MiB;
constexpr size_t WS_SELG = 16 * MiB;
constexpr size_t WS_WPLE = 24 * MiB;
constexpr size_t WS_WIN = 32 * MiB;
constexpr size_t WS_WB8 = 40 * MiB;
constexpr size_t WS_X1B8 = 320 * MiB;
constexpr size_t WS_WG8 = 56 * MiB;
constexpr size_t WS_XB8 = 768 * MiB;
constexpr size_t WS_WV = 80 * MiB;
constexpr size_t WS_WBR = 88 * MiB;
constexpr size_t WS_WO = 100 * MiB;
constexpr size_t WS_WPGQ = 108 * MiB;
constexpr size_t WS_PB = 120 * MiB;
constexpr size_t WS_PU = 128 * MiB;
constexpr size_t WS_PV4 = 144 * MiB;
constexpr size_t WS_PV = 160 * MiB;
constexpr size_t WS_SV4 = 5 * MiB + 131072;
constexpr size_t WS_SU = 5 * MiB, WS_SV = 5 * MiB + 65536;
constexpr size_t WS_XB = 256 * MiB;
constexpr size_t WS_QA = 320 * MiB;
constexpr size_t WS_BG = 352 * MiB;
constexpr size_t WS_QC = 384 * MiB;
constexpr size_t WS_KA = 416 * MiB;
constexpr size_t WS_KC = 448 * MiB;
constexpr size_t WS_VT = 480 * MiB;
constexpr size_t WS_BX = 544 * MiB;
constexpr size_t WS_Y3 = 768 * MiB;
constexpr size_t WS_G = 576 * MiB;
constexpr size_t WS_PW = 576 * MiB;
constexpr size_t WS_PQ = 640 * MiB;
constexpr size_t WS_YB = 768 * MiB;
constexpr size_t WS_AU = 896 * MiB;
constexpr size_t WS_X1B = 896 * MiB;
constexpr size_t WS_END = 960 * MiB;

constexpr int CW_TMO = 0;
constexpr int CW_BAR = 4096;
constexpr int CW_KMAX = 12288;
constexpr int CW_QUEUE = 16384;

constexpr int LDS_BYTES = 147456;
constexpr int MISC_OFF = 131072 + 320;

#define RLX_AGENT __ATOMIC_RELAXED, __HIP_MEMORY_SCOPE_AGENT
#define LDS_WAIT() asm volatile("s_waitcnt lgkmcnt(0)" ::: "memory")
#define VM_WAIT() asm volatile("s_waitcnt vmcnt(0)" ::: "memory")
__device__ __forceinline__ unsigned f2bf(float f) { unsigned u = __builtin_bit_cast(unsigned, f); return (u + 0x7fffu + ((u >> 16) & 1u)) >> 16; }
__device__ __forceinline__ unsigned pk2(float lo, float hi) { return f2bf(lo) | (f2bf(hi) << 16); }
__device__ __forceinline__ unsigned cvtpk(float lo, float hi) { return pg8::cvt_pk_bf16(lo, hi); }
__device__ __forceinline__ float bflo(unsigned w) { return __builtin_bit_cast(float, w << 16); }
__device__ __forceinline__ float bfhi(unsigned w) { return __builtin_bit_cast(float, w & 0xffff0000u); }
__device__ __forceinline__ float fexp(float x) { return __builtin_amdgcn_exp2f(x * LOG2E); }
__device__ __forceinline__ float frcp(float x) { return __builtin_amdgcn_rcpf(x); }
__device__ __forceinline__ float frsq(float x) { return __builtin_amdgcn_rsqf(x); }
__device__ __forceinline__ float flog_sigmoid(float x) { return fminf(x, 0.f) - 0.6931471805599453f * __builtin_amdgcn_logf(1.f + __builtin_amdgcn_exp2f(-LOG2E * fabsf(x))); }
__device__ __forceinline__ float fast_sigmoid(float x) { return __builtin_amdgcn_rcpf(1.f + __builtin_amdgcn_exp2f(-x * LOG2E)); }
__device__ __forceinline__ float wave_sum(float v) {
#pragma unroll
    for (int o = 1; o < 64; o <<= 1) v += __shfl_xor(v, o);
    return v;
}
__device__ __forceinline__ float wave_transpose_reduce64(float (&v)[64], int lane) {
#pragma unroll
    for (int s = 32; s >= 1; s >>= 1) {
        const bool up = (lane & s) != 0;
#pragma unroll
        for (int k = 0; k < s; ++k) { const float a = v[k], b = v[k + s]; const float keep = up ? b : a, send = up ? a : b; v[k] = keep + __shfl_xor(send, s); }
    }
    return v[0];
}

#define XB_TMO      128
#define XB_XCNT(j)  (256  + 64 * (j))
#define XB_XSUB(j)  (1280 + 64 * (j))
#define XB_XGEN(j)  (2304 + 64 * (j))
#define XB_TOP      3328
#define XB_TOPGEN   3392
#define XCD_BAR_WORDS 3456
#define XB_SPIN_CAP (1u << 18)

__device__ __forceinline__ unsigned xb_ld(unsigned* p)              { return __hip_atomic_load(p, __ATOMIC_RELAXED, __HIP_MEMORY_SCOPE_AGENT); }
__device__ __forceinline__ unsigned xb_add(unsigned* p, unsigned v) { return __hip_atomic_fetch_add(p, v, __ATOMIC_RELAXED, __HIP_MEMORY_SCOPE_AGENT); }
__device__ __forceinline__ unsigned xb_xcc_id() { return (unsigned)__builtin_amdgcn_s_getreg((3 << 11) | 20) & 0xFu; }
#define XB_SPIN(cond, bar) do { unsigned _sp = 0; while (cond) { __builtin_amdgcn_s_sleep(1); \
    if ((++_sp & 255u) == 0u) { if (xb_ld(&(bar)[XB_TMO])) break; if (_sp > XB_SPIN_CAP) { atomicAdd(&(bar)[XB_TMO], 1u); break; } } } } while (0)

struct XcdBarrier {
    unsigned* bar; unsigned x;
    volatile LAS unsigned* st;
};

__device__ __forceinline__ XcdBarrier xcd_barrier_post(unsigned* bar, volatile LAS unsigned* st) {
    XcdBarrier b; b.bar = bar; b.x = xb_xcc_id(); b.st = st;
    if (threadIdx.x == 0) (void)xb_add(&bar[XB_XCNT(b.x)], 1u);
    return b;
}
__device__ __forceinline__ void xcd_barrier_complete(unsigned* bar, unsigned x, unsigned& nloc, unsigned& nx) {
    asm volatile("" : "+s"(x));
    const unsigned G = gridDim.x * gridDim.y * gridDim.z;
    unsigned sum, cnt, mine, sp = 0u;
    for (;;) {
        sum = 0u; cnt = 0u; mine = 0u;
#pragma unroll
        for (unsigned j = 0; j < 16; ++j) { const unsigned c = xb_ld(&bar[XB_XCNT(j)]); sum += c; cnt += (c > 0u) ? 1u : 0u; mine = (j == x) ? c : mine; }
        if (sum == G) break;
        __builtin_amdgcn_s_sleep(1);
        if ((++sp & 255u) == 0u) { if (xb_ld(&bar[XB_TMO])) break; if (sp > XB_SPIN_CAP) { atomicAdd(&bar[XB_TMO], 1u); break; } }
    }
    nloc = mine > 0u ? mine : 1u; nx = cnt > 0u ? cnt : 1u;
}

__device__ __forceinline__ void xcd_barrier(const XcdBarrier& b) {
    asm volatile("s_waitcnt vmcnt(0)" ::: "memory");
    __syncthreads();
    if (threadIdx.x == 0) {
        unsigned long long bari_ = (unsigned long long)b.bar; asm volatile("" : "+s"(bari_));
        unsigned* bar = (unsigned*)(GAS unsigned*)bari_;
        __builtin_amdgcn_s_waitcnt(0);
        unsigned nloc = b.st[0], nx = b.st[1];
        if (nloc == 0u) { xcd_barrier_complete(bar, b.x, nloc, nx); b.st[0] = nloc; b.st[1] = nx; }
        const unsigned old = xb_add(&bar[XB_XSUB(b.x)], 1u);
        const unsigned gen = old / nloc;
        if (old + 1u == (gen + 1u) * nloc) {
            __builtin_amdgcn_fence(__ATOMIC_RELEASE, "agent");
            asm volatile("s_waitcnt vmcnt(0)" ::: "memory");
            const unsigned og = xb_add(&bar[XB_TOP], 1u);
            const unsigned tg = og / nx;
            if (og + 1u == (tg + 1u) * nx) xb_add(&bar[XB_TOPGEN], 1u);
            else XB_SPIN(xb_ld(&bar[XB_TOPGEN]) == tg, bar);
            __builtin_amdgcn_fence(__ATOMIC_ACQUIRE, "agent");
            xb_add(&bar[XB_XGEN(b.x)], 1u);
            asm volatile("s_waitcnt vmcnt(0)" ::: "memory");
        } else {
            XB_SPIN(xb_ld(&bar[XB_XGEN(b.x)]) == gen, bar);
            __builtin_amdgcn_fence(__ATOMIC_ACQUIRE, "agent");
            asm volatile("s_waitcnt vmcnt(0)" ::: "memory");
        }
    }
    __syncthreads();
}


using pg8::Unit;
#define EPI_LOOP_BEGIN  _Pragma("unroll") for (int ai = 0; ai < 2; ++ai) _Pragma("unroll") for (int m = 0; m < 4; ++m) { const int row = row0 + ai * 128 + m * 16; _Pragma("unroll") for (int bj = 0; bj < 2; ++bj) { f32x4 v0 = acc[ai][bj][m][0], v1 = acc[ai][bj][m][1]; const int cj = bj * 128;
#define EPI_LOOP_END } }
#define EPI_HALF_BEGIN(ai_) { constexpr int ai = (ai_); _Pragma("unroll") for (int m = 0; m < 4; ++m) { const int row = row0 + ai * 128 + m * 16; _Pragma("unroll") for (int bj = 0; bj < 2; ++bj) { f32x4 v0 = acc[ai][bj][m][0], v1 = acc[ai][bj][m][1]; const int cj = bj * 128;
#define EPI_HALF_END } } }
__device__ __forceinline__ unsigned pack4_fp8(float a, float b, float c, float d, float s) {
    int p = __builtin_amdgcn_cvt_pk_fp8_f32(__builtin_amdgcn_fmed3f(a * s, -448.f, 448.f), __builtin_amdgcn_fmed3f(b * s, -448.f, 448.f), 0, false);
    return (unsigned)__builtin_amdgcn_cvt_pk_fp8_f32(__builtin_amdgcn_fmed3f(c * s, -448.f, 448.f), __builtin_amdgcn_fmed3f(d * s, -448.f, 448.f), p, true);
}
__device__ __forceinline__ u32x2 pack8_fp8(f32x4 v0, f32x4 v1, float s) {
#define F8C(x_) __builtin_amdgcn_fmed3f((x_) * s, -448.f, 448.f)
    int p0 = __builtin_amdgcn_cvt_pk_fp8_f32(F8C(v0[0]), F8C(v0[1]), 0, false); p0 = __builtin_amdgcn_cvt_pk_fp8_f32(F8C(v0[2]), F8C(v0[3]), p0, true);
    int p1 = __builtin_amdgcn_cvt_pk_fp8_f32(F8C(v1[0]), F8C(v1[1]), 0, false); p1 = __builtin_amdgcn_cvt_pk_fp8_f32(F8C(v1[2]), F8C(v1[3]), p1, true);
#undef F8C
    u32x2 o; o.x = (unsigned)p0; o.y = (unsigned)p1; return o;
}
__device__ __forceinline__ u32x4 pack8(f32x4 v0, f32x4 v1) { u32x4 w; w.x = cvtpk(v0[0], v0[1]); w.y = cvtpk(v0[2], v0[3]); w.z = cvtpk(v1[0], v1[1]); w.w = cvtpk(v1[2], v1[3]); return w; }

__device__ __forceinline__ bf16* gate_tile_ptr(bf16* G, int pm, int gz, int wave, int lane) { return G + ((((size_t)(pm * 24 + gz) * 8 + wave) * 16) * 64 + lane) * 8; }
struct EpiInProj {
    static constexpr bool PERM = true, AFTER_DRAIN = false, HOOK = false; static constexpr int HOOK_T0 = -1, HOOK_T1 = -1;
    unsigned char* ws; const float* b_in; int pn_off, jump_at = 1 << 30, jump = 0;
    __device__ __forceinline__ void operator()(const f32x4 (&acc)[2][2][4][2], const Unit& u, int wr, int wc, int fr, int fq) const {
        asm volatile("" : "+v"(fr));
        const int row0 = u.pm * 256 + wr * 64 + fr, colt = (u.pn + pn_off + (u.pn >= jump_at ? jump : 0)) * 256;
        bf16* base; int ldc, c0, bcol; float sc = 1.f;
        if (colt < 6144) { const int t = colt >> 10; c0 = colt & 1023; ldc = 1024;
            const size_t off = t == 0 ? WS_QA : t == 1 ? WS_KA : t == 2 ? WS_BX : t == 3 ? WS_BG : t == 4 ? WS_QC : WS_KC;
            base = (bf16*)(ws + off); sc = t == 0 ? SCALE_A : (t == 4 ? SCALE_C : 1.f);
            bcol = colt < 2048 ? colt : colt + 1024; }
        else { base = (bf16*)(ws + WS_G); ldc = 6144; c0 = colt - 6144; bcol = colt - 6144 + COL_GATE; }
        const bool gate = colt >= 6144;
        bf16* gt = gate_tile_ptr((bf16*)(ws + WS_G), u.pm, (colt - 6144) >> 8, wr * 4 + wc, fq * 16 + (fr & 15));
        const int col0 = c0 + wc * 32 + 8 * fq; const float* bp = b_in + bcol + wc * 32 + 8 * fq;
        f32x4 bv[2][2];
#pragma unroll
        for (int bj = 0; bj < 2; ++bj)
#pragma unroll
            for (int n = 0; n < 2; ++n) bv[bj][n] = *(const f32x4*)(bp + bj * 128 + 4 * n);
        EPI_LOOP_BEGIN
            v0 = (v0 + bv[bj][0]) * sc; v1 = (v1 + bv[bj][1]) * sc;
            if (gate) {
#pragma unroll
                for (int i = 0; i < 4; ++i) { v0[i] = __builtin_amdgcn_exp2f(-LOG2E * fminf(fmaxf(v0[i], -30.f), 30.f)); v1[i] = __builtin_amdgcn_exp2f(-LOG2E * fminf(fmaxf(v1[i], -30.f), 30.f)); }
                *(u32x4*)(gt + ((ai * 4 + m) * 2 + bj) * 512) = pack8(v0, v1); }
            else *(u32x4*)(base + (size_t)row * ldc + col0 + cj) = pack8(v0, v1);
        EPI_LOOP_END
    }
};
struct EpiVT {
    static constexpr bool PERM = true, AFTER_DRAIN = false, HOOK = false; static constexpr int HOOK_T0 = -1, HOOK_T1 = -1;
    bf16* VT; const float* b_in;
    __device__ __forceinline__ void operator()(const f32x4 (&acc)[2][2][4][2], const Unit& u, int wr, int wc, int fr, int fq) const {
        asm volatile("" : "+v"(fr));
        const int row0 = u.pm * 256 + wr * 64 + fr, col0 = u.pn * 256 + wc * 32 + 8 * fq;
        const float* bp = b_in + (u.pm < 4 ? 2048 : 7168 - 1024);
        EPI_LOOP_BEGIN
            const float br = bp[row];
            v0 = v0 + br; v1 = v1 + br;
            *(u32x4*)(VT + (size_t)row * M + col0 + cj) = pack8(v0, v1);
        EPI_LOOP_END
    }
};
struct EpiMerge {
    static constexpr bool PERM = true, AFTER_DRAIN = false, HOOK = true; static constexpr int HOOK_T0 = 8, HOOK_T1 = 16;
    const bf16* G; bf16* O;
    static __device__ __forceinline__ float e2(float g) { return __builtin_amdgcn_exp2f(-LOG2E * fminf(fmaxf(g, -30.f), 30.f)); }
    __device__ __forceinline__ void hook(f32x4 (&acc)[2][2][4][2], const Unit& u, int t, int wr, int wc, int fr, int fq) const {
        asm volatile("" : "+v"(fr));
        const int z = t == HOOK_T0 ? 0 : 1, ln = fq * 16 + (fr & 15);
        const bf16* ga_ = gate_tile_ptr((bf16*)G, u.pm, z * 8 + u.pn, wr * 4 + wc, ln); const bf16* gb_ = gate_tile_ptr((bf16*)G, u.pm, (z + 1) * 8 + u.pn, wr * 4 + wc, ln);
#pragma unroll
        for (int ai = 0; ai < 2; ++ai) {
            u32x4 pa[8], pb[8];
#pragma unroll
            for (int q = 0; q < 8; ++q) { pa[q] = *(const u32x4*)(ga_ + (ai * 8 + q) * 512); pb[q] = *(const u32x4*)(gb_ + (ai * 8 + q) * 512); }
            __builtin_amdgcn_sched_barrier(0);
#pragma unroll
            for (int m = 0; m < 4; ++m)
#pragma unroll
                for (int bj = 0; bj < 2; ++bj) { const u32x4 ga = pa[m * 2 + bj], gb = pb[m * 2 + bj];
                    const float a[8] = {bflo(ga.x), bfhi(ga.x), bflo(ga.y), bfhi(ga.y), bflo(ga.z), bfhi(ga.z), bflo(ga.w), bfhi(ga.w)};
                    const float b[8] = {bflo(gb.x), bfhi(gb.x), bflo(gb.y), bfhi(gb.y), bflo(gb.z), bfhi(gb.z), bflo(gb.w), bfhi(gb.w)};
#pragma unroll
                    for (int i = 0; i < 4; ++i) { acc[ai][bj][m][0][i] *= (1.f + b[i]) * __builtin_amdgcn_rcpf(1.f + a[i]); acc[ai][bj][m][1][i] *= (1.f + b[4 + i]) * __builtin_amdgcn_rcpf(1.f + a[4 + i]); } }
        }
    }
    __device__ __forceinline__ void operator()(const f32x4 (&acc)[2][2][4][2], const Unit& u, int wr, int wc, int fr, int fq) const {
        asm volatile("" : "+v"(fr));
        const int row0 = u.pm * 256 + wr * 64 + fr, col0 = u.pn * 256 + wc * 32 + 8 * fq;
        const bf16* g2_ = gate_tile_ptr((bf16*)G, u.pm, 16 + u.pn, wr * 4 + wc, fq * 16 + (fr & 15));
        { u32x4 pre[8];
#pragma unroll
          for (int q = 0; q < 8; ++q) pre[q] = *(const u32x4*)(g2_ + (0 * 8 + q) * 512);
          __builtin_amdgcn_sched_barrier(0);
          EPI_HALF_BEGIN(0)
            const u32x4 gw = pre[m * 2 + bj];
            const float g[8] = {bflo(gw.x), bfhi(gw.x), bflo(gw.y), bfhi(gw.y), bflo(gw.z), bfhi(gw.z), bflo(gw.w), bfhi(gw.w)};
#pragma unroll
            for (int i = 0; i < 4; ++i) { v0[i] *= __builtin_amdgcn_rcpf(1.f + g[i]); v1[i] *= __builtin_amdgcn_rcpf(1.f + g[4 + i]); }
            *(u32x2*)((unsigned char*)O + (size_t)row * 2048 + col0 + cj) = pack8_fp8(v0, v1, 8.f);
          EPI_HALF_END }
        { u32x4 pre[8];
#pragma unroll
          for (int q = 0; q < 8; ++q) pre[q] = *(const u32x4*)(g2_ + (1 * 8 + q) * 512);
          __builtin_amdgcn_sched_barrier(0);
          EPI_HALF_BEGIN(1)
            const u32x4 gw = pre[m * 2 + bj];
            const float g[8] = {bflo(gw.x), bfhi(gw.x), bflo(gw.y), bfhi(gw.y), bflo(gw.z), bfhi(gw.z), bflo(gw.w), bfhi(gw.w)};
#pragma unroll
            for (int i = 0; i < 4; ++i) { v0[i] *= __builtin_amdgcn_rcpf(1.f + g[i]); v1[i] *= __builtin_amdgcn_rcpf(1.f + g[4 + i]); }
            *(u32x2*)((unsigned char*)O + (size_t)row * 2048 + col0 + cj) = pack8_fp8(v0, v1, 8.f);
          EPI_HALF_END }
    }
};
struct EpiWo {
    static constexpr bool PERM = true, AFTER_DRAIN = false, HOOK = false; static constexpr int HOOK_T0 = -1, HOOK_T1 = -1;
    const bf16* xres; bf16* Y;
    __device__ __forceinline__ void operator()(const f32x4 (&acc)[2][2][4][2], const Unit& u, int wr, int wc, int fr, int fq) const {
        asm volatile("" : "+v"(fr));
        const int row0 = u.pm * 256 + wr * 64 + fr, col0 = u.pn * 256 + wc * 32 + 8 * fq;
        { u32x4 pre[8];
#pragma unroll
          for (int q = 0; q < 8; ++q) pre[q] = *(const u32x4*)(xres + (size_t)(row0 + 0 * 128 + (q >> 1) * 16) * 2048 + col0 + (q & 1) * 128);
          __builtin_amdgcn_sched_barrier(0);
          EPI_HALF_BEGIN(0)
            const u32x4 xr = pre[m * 2 + bj];
            const size_t o = (size_t)row * 2048 + col0 + cj;
            v0 += ALPHA * (f32x4){bflo(xr.x), bfhi(xr.x), bflo(xr.y), bfhi(xr.y)}; v1 += ALPHA * (f32x4){bflo(xr.z), bfhi(xr.z), bflo(xr.w), bfhi(xr.w)};
            *(u32x4*)(Y + o) = pack8(v0, v1);
          EPI_HALF_END }
        { u32x4 pre[8];
#pragma unroll
          for (int q = 0; q < 8; ++q) pre[q] = *(const u32x4*)(xres + (size_t)(row0 + 1 * 128 + (q >> 1) * 16) * 2048 + col0 + (q & 1) * 128);
          __builtin_amdgcn_sched_barrier(0);
          EPI_HALF_BEGIN(1)
            const u32x4 xr = pre[m * 2 + bj];
            const size_t o = (size_t)row * 2048 + col0 + cj;
            v0 += ALPHA * (f32x4){bflo(xr.x), bfhi(xr.x), bflo(xr.y), bfhi(xr.y)}; v1 += ALPHA * (f32x4){bflo(xr.z), bfhi(xr.z), bflo(xr.w), bfhi(xr.w)};
            *(u32x4*)(Y + o) = pack8(v0, v1);
          EPI_HALF_END }
    }
};
struct EpiPlain {
    static constexpr bool PERM = true, AFTER_DRAIN = false, HOOK = false; static constexpr int HOOK_T0 = -1, HOOK_T1 = -1;
    bf16* O; int ldc;
    __device__ __forceinline__ void operator()(const f32x4 (&acc)[2][2][4][2], const Unit& u, int wr, int wc, int fr, int fq) const {
        asm volatile("" : "+v"(fr));
        const int row0 = u.pm * 256 + wr * 64 + fr, col0 = u.pn * 256 + wc * 32 + 8 * fq;
        EPI_LOOP_BEGIN
            *(u32x4*)(O + (size_t)row * ldc + col0 + cj) = pack8(v0, v1);
        EPI_LOOP_END
    }
};
struct EpiPgq {
    static constexpr bool PERM = true, AFTER_DRAIN = false, HOOK = false; static constexpr int HOOK_T0 = -1, HOOK_T1 = -1;
    bf16* PW; bf16* PQ; const float* bpg; bf16* PLEo; int pn_off;
    __device__ __forceinline__ void operator()(const f32x4 (&acc)[2][2][4][2], const Unit& u, int wr, int wc, int fr, int fq) const {
        asm volatile("" : "+v"(fr));
        const int row0 = u.pm * 256 + wr * 64 + fr, colt = (u.pn + pn_off) * 256, cw = wc * 32 + 8 * fq;
        if (colt < 2048) {
            const int col0 = colt + cw;
            f32x4 bv[2][2];
#pragma unroll
            for (int bj = 0; bj < 2; ++bj)
#pragma unroll
                for (int n = 0; n < 2; ++n) bv[bj][n] = *(const f32x4*)(bpg + col0 + bj * 128 + 4 * n);
        { u32x4 pre[8];
#pragma unroll
          for (int q = 0; q < 8; ++q) pre[q] = *(const u32x4*)(PW + (size_t)(row0 + 0 * 128 + (q >> 1) * 16) * 2048 + col0 + (q & 1) * 128);
          __builtin_amdgcn_sched_barrier(0);
          EPI_HALF_BEGIN(0)
            const u32x4 pw = pre[m * 2 + bj];
                const size_t po = (size_t)row * 2048 + col0 + cj;
                f32x4 p0 = {bflo(pw.x), bfhi(pw.x), bflo(pw.y), bfhi(pw.y)}, p1 = {bflo(pw.z), bfhi(pw.z), bflo(pw.w), bfhi(pw.w)};
                v0 += bv[bj][0]; v1 += bv[bj][1];
#pragma unroll
                for (int i = 0; i < 4; ++i) { v0[i] = fast_sigmoid(v0[i]) * p0[i]; v1[i] = fast_sigmoid(v1[i]) * p1[i]; }
                *(u32x4*)(PLEo + po) = pack8(v0, v1);
          EPI_HALF_END }
        { u32x4 pre[8];
#pragma unroll
          for (int q = 0; q < 8; ++q) pre[q] = *(const u32x4*)(PW + (size_t)(row0 + 1 * 128 + (q >> 1) * 16) * 2048 + col0 + (q & 1) * 128);
          __builtin_amdgcn_sched_barrier(0);
          EPI_HALF_BEGIN(1)
            const u32x4 pw = pre[m * 2 + bj];
                const size_t po = (size_t)row * 2048 + col0 + cj;
                f32x4 p0 = {bflo(pw.x), bfhi(pw.x), bflo(pw.y), bfhi(pw.y)}, p1 = {bflo(pw.z), bfhi(pw.z), bflo(pw.w), bfhi(pw.w)};
                v0 += bv[bj][0]; v1 += bv[bj][1];
#pragma unroll
                for (int i = 0; i < 4; ++i) { v0[i] = fast_sigmoid(v0[i]) * p0[i]; v1[i] = fast_sigmoid(v1[i]) * p1[i]; }
                *(u32x4*)(PLEo + po) = pack8(v0, v1);
          EPI_HALF_END }
        } else {
            const int col0 = colt - 2048 + cw;
            EPI_LOOP_BEGIN
                *(u32x4*)(PQ + (size_t)row * 1024 + col0 + cj) = pack8(v0, v1);
            EPI_LOOP_END
        }
    }
};
struct MergeOrder {
    pg8::StaticOrder S;
    __device__ __forceinline__ bool next(int i, Unit& u) const { const int t = i / 3; if (!S.next(t, u)) return false; u.z = i - 3 * t; return true; }
    __device__ __forceinline__ void a_ready(const Unit&) const {}
    __device__ __forceinline__ void done(const Unit&) const {}
};

struct Ctx {
    LAS unsigned char* lds; unsigned char* ws; gu32* ctl;
    int tid, lane, wave, G, gw, NGW, bid;
};
__device__ __forceinline__ Ctx fresh_ctx(const Ctx& C) {
    Ctx P = C; int t = C.tid; asm volatile("" : "+v"(t)); unsigned long long wi = (unsigned long long)C.ws; asm volatile("" : "+s"(wi));
    unsigned char* w = (unsigned char*)(GAS unsigned char*)wi;
    int bid = blockIdx.x, G = gridDim.x; asm volatile("" : "+s"(bid), "+s"(G));
    P.tid = t; P.lane = t & 63; P.wave = __builtin_amdgcn_readfirstlane(t >> 6); P.ws = w; P.ctl = (gu32*)(w + WS_CTL); P.bid = bid; P.G = G; P.gw = bid * NWAVES + P.wave; P.NGW = G * NWAVES; return P;
}

template <bool FP8OUT = false>
__device__ __forceinline__ void transpose_item(const float* W, int ldw, int col0, int K, bf16* WT, int rowoff, LAS float* scr, int kb, int nb, int lane, int ldt = 0) {
    if (ldt == 0) ldt = K;
    const int k0 = 64 * kb, n0 = 32 * nb;
    { f32x4 v[8]; const int c4 = 4 * (lane & 7), r8 = lane >> 3;
#pragma unroll
      for (int i = 0; i < 8; ++i) v[i] = *(const f32x4*)(W + (size_t)(k0 + 8 * i + r8) * ldw + col0 + n0 + c4);
#pragma unroll
      for (int i = 0; i < 8; ++i) { LAS float* d = scr + (8 * i + r8) * 33 + c4; d[0] = v[i][0]; d[1] = v[i][1]; d[2] = v[i][2]; d[3] = v[i][3]; } }
    LDS_WAIT(); asm volatile("" ::: "memory");
    const int c = lane & 7;
#pragma unroll
    for (int j = 0; j < 4; ++j) { const int n = (lane >> 3) + 8 * j; const LAS float* s = scr + (8 * c) * 33 + n;
        if constexpr (FP8OUT) { int p0 = __builtin_amdgcn_cvt_pk_fp8_f32(s[0 * 33] * 64.f, s[1 * 33] * 64.f, 0, false); p0 = __builtin_amdgcn_cvt_pk_fp8_f32(s[2 * 33] * 64.f, s[3 * 33] * 64.f, p0, true);
            int p1 = __builtin_amdgcn_cvt_pk_fp8_f32(s[4 * 33] * 64.f, s[5 * 33] * 64.f, 0, false); p1 = __builtin_amdgcn_cvt_pk_fp8_f32(s[6 * 33] * 64.f, s[7 * 33] * 64.f, p1, true);
            u32x2 o; o.x = (unsigned)p0; o.y = (unsigned)p1; *(u32x2*)((unsigned char*)WT + (size_t)(rowoff + n0 + n) * ldt + k0 + 8 * c) = o; }
        else { u32x4 o; o.x = pk2(s[0 * 33], s[1 * 33]); o.y = pk2(s[2 * 33], s[3 * 33]); o.z = pk2(s[4 * 33], s[5 * 33]); o.w = pk2(s[6 * 33], s[7 * 33]);
            *(u32x4*)(WT + (size_t)(rowoff + n0 + n) * ldt + k0 + 8 * c) = o; } }
    LDS_WAIT(); asm volatile("" ::: "memory");
}
__device__ __forceinline__ void cvt_rows(const Ctx& C, const float* __restrict__ src, bf16* __restrict__ dst, size_t n) {
    const size_t nth = (size_t)C.G * NTHR, t0 = (size_t)C.bid * NTHR + C.tid;
    for (size_t i = t0; i < n / 8; i += nth) { const f32x4 a = *(const f32x4*)(src + 8 * i), b = *(const f32x4*)(src + 8 * i + 4);
        u32x4 o; o.x = pk2(a[0], a[1]); o.y = pk2(a[2], a[3]); o.z = pk2(b[0], b[1]); o.w = pk2(b[2], b[3]); *(u32x4*)(dst + 8 * i) = o; }
}
constexpr int P6ROW = 1536;
__device__ __forceinline__ unsigned fp6_code(float v, float inv) {
    const float a = fminf(fabsf(v * inv), 7.5f);
    int e = (int)(__builtin_bit_cast(unsigned, a) >> 23) - 127; e = e < 0 ? 0 : (e > 2 ? 2 : e);
    const unsigned q = (unsigned)__builtin_rintf(__builtin_amdgcn_ldexpf(a, 3 - e));
    return (q + 8u * (unsigned)e) | ((__builtin_bit_cast(unsigned, v) >> 26) & 0x20u);
}
__device__ __forceinline__ void cvt_rows_fp6(const Ctx& C, const float* src, unsigned char* dst, float* scales, int nrows) {
    for (int r = C.gw; r < nrows; r += C.NGW) {
        const float* sp = src + (size_t)r * DM + 16 * C.lane; f32x4 v[2][4]; float am = 0.f;
#pragma unroll
        for (int j = 0; j < 2; ++j)
#pragma unroll
            for (int q = 0; q < 4; ++q) { v[j][q] = *(const f32x4*)(sp + 1024 * j + 4 * q); am = fmaxf(am, fmaxf(fmaxf(fabsf(v[j][q][0]), fabsf(v[j][q][1])), fmaxf(fabsf(v[j][q][2]), fabsf(v[j][q][3])))); }
#pragma unroll
        for (int o = 1; o < 64; o <<= 1) am = fmaxf(am, __shfl_xor(am, o));
        const float sc = am > 0.f ? am * (1.f / 7.5f) : 1.f, inv = frcp(sc);
#pragma unroll
        for (int j = 0; j < 2; ++j) { unsigned c[16];
#pragma unroll
            for (int i = 0; i < 16; ++i) c[i] = fp6_code(v[j][i >> 2][i & 3], inv);
            unsigned* dp = (unsigned*)(dst + (size_t)r * P6ROW + 768 * j) + 3 * C.lane;
            dp[0] = c[0] | (c[1] << 6) | (c[2] << 12) | (c[3] << 18) | (c[4] << 24) | (c[5] << 30);
            dp[1] = (c[5] >> 2) | (c[6] << 4) | (c[7] << 10) | (c[8] << 16) | (c[9] << 22) | (c[10] << 28);
            dp[2] = (c[10] >> 4) | (c[11] << 2) | (c[12] << 8) | (c[13] << 14) | (c[14] << 20) | (c[15] << 26); }
        if (C.lane == 0) scales[r] = sc;
    }
}
constexpr int P4ROW = 1024;
__device__ __forceinline__ unsigned fp4_code(float v, float inv) {
    const float a = fminf(fabsf(v * inv), 6.f);
    int e = (int)(__builtin_bit_cast(unsigned, a) >> 23) - 127; e = e < 0 ? 0 : (e > 2 ? 2 : e);
    const unsigned q = (unsigned)__builtin_rintf(__builtin_amdgcn_ldexpf(a, 1 - e));
    return (q + 2u * (unsigned)e) | ((__builtin_bit_cast(unsigned, v) >> 28) & 0x8u);
}
__device__ __forceinline__ void cvt_rows_fp4(const Ctx& C, const float* src, unsigned char* dst, float* scales, int nrows) {
    for (int r = C.gw; r < nrows; r += C.NGW) {
        const float* sp = src + (size_t)r * DM + 16 * C.lane; f32x4 v[2][4]; float am = 0.f;
#pragma unroll
        for (int j = 0; j < 2; ++j)
#pragma unroll
            for (int q = 0; q < 4; ++q) { v[j][q] = *(const f32x4*)(sp + 1024 * j + 4 * q); am = fmaxf(am, fmaxf(fmaxf(fabsf(v[j][q][0]), fabsf(v[j][q][1])), fmaxf(fabsf(v[j][q][2]), fabsf(v[j][q][3])))); }
#pragma unroll
        for (int o = 1; o < 64; o <<= 1) am = fmaxf(am, __shfl_xor(am, o));
        const float sc = am > 0.f ? am * (0.85f / 6.f) : 1.f, inv = frcp(sc);
        unsigned d[4];
#pragma unroll
        for (int h = 0; h < 4; ++h) { unsigned w = 0u;
#pragma unroll
            for (int i = 0; i < 8; ++i) w |= fp4_code(v[h >> 1][2 * (h & 1) + (i >> 2)][i & 3], inv) << (4 * i);
            d[h] = w; }
        u32x4 o; o.x = d[0]; o.y = d[1]; o.z = d[2]; o.w = d[3];
        *(u32x4*)(dst + (size_t)r * P4ROW + 16 * C.lane) = o;
        if (C.lane == 0) scales[r] = sc;
    }
}
__device__ __forceinline__ void cvt_rows_fp6_fp4(const Ctx& C, const float* src, unsigned char* dst6, float* scales6, unsigned char* dst4, float* scales4, int nrows) {
    for (int r = C.gw; r < nrows; r += C.NGW) {
        const float* sp = src + (size_t)r * DM + 16 * C.lane; f32x4 v[2][4]; float am = 0.f;
#pragma unroll
        for (int j = 0; j < 2; ++j)
#pragma unroll
            for (int q = 0; q < 4; ++q) { v[j][q] = *(const f32x4*)(sp + 1024 * j + 4 * q); am = fmaxf(am, fmaxf(fmaxf(fabsf(v[j][q][0]), fabsf(v[j][q][1])), fmaxf(fabsf(v[j][q][2]), fabsf(v[j][q][3])))); }
#pragma unroll
        for (int o = 1; o < 64; o <<= 1) am = fmaxf(am, __shfl_xor(am, o));
        const float sc6 = am > 0.f ? am * (1.f / 7.5f) : 1.f, inv6 = frcp(sc6), sc4 = am > 0.f ? am * (0.85f / 6.f) : 1.f, inv4 = frcp(sc4);
#pragma unroll
        for (int j = 0; j < 2; ++j) { unsigned c[16];
#pragma unroll
            for (int i = 0; i < 16; ++i) c[i] = fp6_code(v[j][i >> 2][i & 3], inv6);
            unsigned* dp = (unsigned*)(dst6 + (size_t)r * P6ROW + 768 * j) + 3 * C.lane;
            dp[0] = c[0] | (c[1] << 6) | (c[2] << 12) | (c[3] << 18) | (c[4] << 24) | (c[5] << 30);
            dp[1] = (c[5] >> 2) | (c[6] << 4) | (c[7] << 10) | (c[8] << 16) | (c[9] << 22) | (c[10] << 28);
            dp[2] = (c[10] >> 4) | (c[11] << 2) | (c[12] << 8) | (c[13] << 14) | (c[14] << 20) | (c[15] << 26); }
        unsigned d[4];
#pragma unroll
        for (int h = 0; h < 4; ++h) { unsigned w = 0u;
#pragma unroll
            for (int i = 0; i < 8; ++i) w |= fp4_code(v[h >> 1][2 * (h & 1) + (i >> 2)][i & 3], inv4) << (4 * i);
            d[h] = w; }
        u32x4 o; o.x = d[0]; o.y = d[1]; o.z = d[2]; o.w = d[3];
        *(u32x4*)(dst4 + (size_t)r * P4ROW + 16 * C.lane) = o;
        if (C.lane == 0) { scales6[r] = sc6; scales4[r] = sc4; }
    }
}
template <bool F32SRC>
__device__ __forceinline__ void fc_phase(const Ctx& C, const float* __restrict__ xsrc, const bf16* __restrict__ xsrcb, const float* __restrict__ w_in, const float* __restrict__ b_in, bf16* __restrict__ xcopy, unsigned char* __restrict__ x8) {
    LAS float* Wl = (LAS float*)C.lds;
    { float t[32];
#pragma unroll
      for (int q = 0; q < 32; ++q) { const int i = C.tid + q * NTHR; t[q] = w_in[(size_t)(i >> 3) * IN_TOTAL + COL_FC + (i & 7)]; }
#pragma unroll
      for (int q = 0; q < 32; ++q) { const int i = C.tid + q * NTHR; Wl[(i & 7) * 2048 + (i >> 3)] = t[q]; } }
    __syncthreads();
    float* LOGF = (float*)(C.ws + WS_LOGF);
    for (int rb = C.gw; rb < M / 8; rb += C.NGW) {
        const int m0 = rb * 8;
        float acc[64];
#pragma unroll
        for (int i = 0; i < 64; ++i) acc[i] = 0.f;
        f32x4 xa[8]; u32x2 ra[8];
#define FC_LOAD(XV, RV, j_) _Pragma("unroll") for (int r = 0; r < 8; ++r) { if constexpr (F32SRC) XV[r] = *(const f32x4*)(xsrc + (size_t)(m0 + r) * DM + 256 * (j_) + 4 * C.lane); \
            else RV[r] = *(const u32x2*)(xsrcb + (size_t)(m0 + r) * DM + 256 * (j_) + 4 * C.lane); }
#define FC_STEP(XV, RV, j_) { f32x4 wv[8]; _Pragma("unroll") for (int h = 0; h < 8; ++h) wv[h] = *(const LAS f32x4*)(Wl + h * 2048 + 256 * (j_) + 4 * C.lane); \
            _Pragma("unroll") for (int r = 0; r < 8; ++r) { f32x4 xv; if constexpr (F32SRC) { xv = XV[r]; *(u32x2*)(xcopy + (size_t)(m0 + r) * DM + 256 * (j_) + 4 * C.lane) = (u32x2){pk2(xv[0], xv[1]), pk2(xv[2], xv[3])}; } \
                else xv = (f32x4){bflo(RV[r].x), bfhi(RV[r].x), bflo(RV[r].y), bfhi(RV[r].y)}; \
                { int p8_ = __builtin_amdgcn_cvt_pk_fp8_f32(__builtin_amdgcn_fmed3f(xv[0], -448.f, 448.f), __builtin_amdgcn_fmed3f(xv[1], -448.f, 448.f), 0, false); p8_ = __builtin_amdgcn_cvt_pk_fp8_f32(__builtin_amdgcn_fmed3f(xv[2], -448.f, 448.f), __builtin_amdgcn_fmed3f(xv[3], -448.f, 448.f), p8_, true); \
                  *(unsigned*)(x8 + (size_t)(m0 + r) * DM + 256 * (j_) + 4 * C.lane) = (unsigned)p8_; } \
                _Pragma("unroll") for (int h = 0; h < 8; ++h) acc[r * 8 + h] += (xv[0] * wv[h][0] + xv[1] * wv[h][1]) + (xv[2] * wv[h][2] + xv[3] * wv[h][3]); } }
#pragma unroll 1
        for (int j = 0; j < 8; ++j) {
            FC_LOAD(xa, ra, j) __builtin_amdgcn_sched_barrier(0);
            FC_STEP(xa, ra, j) __builtin_amdgcn_sched_barrier(0);
        }
#undef FC_LOAD
#undef FC_STEP
        const float tot = wave_transpose_reduce64(acc, C.lane);
        const int r = C.lane >> 3, h = C.lane & 7, m = m0 + r, b = m / SEQ, s = m % SEQ;
        const float fc = tot + b_in[COL_FC + h];
        const float lf = fminf(fc, 0.f) - 0.6931471805599453f * __builtin_amdgcn_logf(1.f + __builtin_amdgcn_exp2f(-LOG2E * fabsf(fc)));
        LOGF[(size_t)(b * 8 + h) * SEQ + s] = lf;
    }
    __syncthreads();
}
__device__ __forceinline__ void cumsum_seq(const Ctx& C, int seq) {
    const float* src = (const float*)(C.ws + WS_LOGF) + (size_t)seq * SEQ + 128 * C.lane;
    float* dst = (float*)(C.ws + WS_CUM2) + (size_t)seq * SEQ + 128 * C.lane;
    float tot = 0.f;
    for (int i = 0; i < 32; ++i) { const f32x4 v = *(const f32x4*)(src + 4 * i); tot += (v[0] + v[1]) + (v[2] + v[3]); }
    float inc = tot;
#pragma unroll
    for (int o = 1; o < 64; o <<= 1) { const float t = __shfl_up(inc, o); if (C.lane >= o) inc += t; }
    float run = inc - tot;
    for (int i = 0; i < 32; ++i) { const f32x4 v = *(const f32x4*)(src + 4 * i); f32x4 o;
        run += v[0]; o[0] = run * LOG2E; run += v[1]; o[1] = run * LOG2E; run += v[2]; o[2] = run * LOG2E; run += v[3]; o[3] = run * LOG2E;
        *(f32x4*)(dst + 4 * i) = o; }
}
struct InPtrs { const float* in[27]; };
#define CAS __attribute__((address_space(4)))
struct InRef { const float* const CAS* p; __device__ __forceinline__ const float* in(int k) const { return (const float*)(GAS const float*)p[k]; } };
__device__ __forceinline__ InRef fresh_in() { unsigned o = 0; asm volatile("" : "+s"(o)); return InRef{(const float* const CAS*)((const char CAS*)__builtin_amdgcn_kernarg_segment_ptr() + o)}; }
__device__ __forceinline__ void prologue_phase(const Ctx& C, const InRef& I, int L, const float* xsrc) {
    if (L == 0) fc_phase<true>(C, xsrc, nullptr, I.in(2) + (size_t)L * DM * IN_TOTAL, I.in(3) + (size_t)L * IN_TOTAL, (bf16*)(C.ws + WS_XB), C.ws + WS_XB8);
    else fc_phase<false>(C, nullptr, (const bf16*)(C.ws + WS_XB), I.in(2) + (size_t)L * DM * IN_TOTAL, I.in(3) + (size_t)L * IN_TOTAL, nullptr, C.ws + WS_XB8);
    LAS float* scr = (LAS float*)(C.lds + C.wave * 8448);
    const float* w_in = I.in(2) + (size_t)L * DM * IN_TOTAL;
    const float* w_br = I.in(14) + (size_t)L * 3 * 1024 * 2048;
    const float* w_o = I.in(15) + (size_t)L * 2048 * 2048;
    const float* w_q = I.in(18) + (size_t)L * 2048 * 1024;
    const float* w_ple = I.in(22) + (size_t)L * 256 * 2048;
    const float* w_pg = I.in(23) + (size_t)L * 2048 * 2048;
    bf16* WIN = (bf16*)(C.ws + WS_WIN); bf16* WV = (bf16*)(C.ws + WS_WV); bf16* WBR = (bf16*)(C.ws + WS_WBR); bf16* WO = (bf16*)(C.ws + WS_WO);
    bf16* WPGQ = (bf16*)(C.ws + WS_WPGQ); bf16* WPLE = (bf16*)(C.ws + WS_WPLE);
    constexpr int I_IN0 = 32 * 64, I_VA = 32 * 32, I_IN1 = 32 * 128, I_VC = 32 * 32, I_G = 32 * 192, I_BR = 16 * 64, I_O = 32 * 64, I_PG = 32 * 64, I_Q = 32 * 32, I_PLE = 4 * 64;
    constexpr int NITEMS = I_IN0 + I_VA + I_IN1 + I_VC + I_G + 3 * I_BR + I_O + I_PG + I_Q + I_PLE;
#define TJL(src, ldw, col0, K, ncols, dst, rowoff, ldt) { constexpr int ni_ = ((K) / 64) * ((ncols) / 32); if (r < ni_) { constexpr int nblk_ = (ncols) / 32; transpose_item(src, ldw, col0, K, dst, rowoff, scr, r / nblk_, r % nblk_, C.lane, ldt); continue; } r -= ni_; }
#define TJ(src, ldw, col0, K, ncols, dst, rowoff) TJL(src, ldw, col0, K, ncols, dst, rowoff, 0)
#define TJ8(src, ldw, col0, K, ncols, dst, rowoff) { constexpr int ni_ = ((K) / 64) * ((ncols) / 32); if (r < ni_) { constexpr int nblk_ = (ncols) / 32; transpose_item<true>(src, ldw, col0, K, dst, rowoff, scr, r / nblk_, r % nblk_, C.lane, K); continue; } r -= ni_; }
    for (int it = C.gw; it < NITEMS; it += C.NGW) {
        int r = it;
        TJ8(w_in, IN_TOTAL, 0, 2048, 2048, WIN, 0)
        TJ8(w_in, IN_TOTAL, 2048, 2048, 1024, WV, 0)
        TJ8(w_in, IN_TOTAL, 3072, 2048, 4096, WIN, 2048)
        TJ8(w_in, IN_TOTAL, 7168, 2048, 1024, WV, 1024)
        TJ8(w_in, IN_TOTAL, COL_GATE, 2048, 6144, WIN, 6144)
#define TJ8L(src, ldw, col0, K, ncols, dst, rowoff, ldt) { constexpr int ni_ = ((K) / 64) * ((ncols) / 32); if (r < ni_) { constexpr int nblk_ = (ncols) / 32; transpose_item<true>(src, ldw, col0, K, dst, rowoff, scr, r / nblk_, r % nblk_, C.lane, ldt); continue; } r -= ni_; }
        TJ8L(w_br, 2048, 0, 1024, 2048, WBR, 0, 3072)
        TJ8L(w_br + 1024 * 2048, 2048, 0, 1024, 2048, (bf16*)((unsigned char*)WBR + 1024), 0, 3072)
        TJ8L(w_br + 2 * 1024 * 2048, 2048, 0, 1024, 2048, (bf16*)((unsigned char*)WBR + 2048), 0, 3072)
        TJ8(w_o, 2048, 0, 2048, 2048, WO, 0)
        TJ8(w_pg, 2048, 0, 2048, 2048, WPGQ, 0)
        TJ(w_q, 1024, 0, 2048, 1024, WPGQ, 2048)
        TJ(w_ple, 2048, 0, 256, 2048, WPLE, 0)
    }
#undef TJ
#undef TJ8
#undef TJ8L
#undef TJL
    static_assert(I_IN0 == 2048 && I_G == 6144 && NITEMS > 0, "items");
    cvt_rows_fp4(C, I.in(20) + (size_t)L * NEXP * DM, C.ws + WS_PU, (float*)(C.ws + WS_SU), NEXP);
    cvt_rows_fp4(C, I.in(21) + (size_t)L * NEXP * DM, C.ws + WS_PV4, (float*)(C.ws + WS_SV4), NEXP);
    cvt_rows(C, I.in(19) + (size_t)L * 131072, (bf16*)(C.ws + WS_KEYS), 131072);
    cvt_rows(C, I.in(1) + (size_t)L * M * 256, (bf16*)(C.ws + WS_PB), (size_t)M * 256);
    { const float* wa = I.in(9) + (size_t)L * 131072; const float* wx = I.in(11) + (size_t)L * 131072;
      bf16* WLA = (bf16*)(C.ws + WS_WLA); bf16* WLX = (bf16*)(C.ws + WS_WLX);
      for (int o = C.bid * NTHR + C.tid; o < 131072; o += C.G * NTHR) { const int g = o >> 14, j = (o >> 7) & 127, i = o & 127; const int src = (g * 128 + i) * 128 + j;
          WLA[o] = (bf16)f2bf(wa[src]); WLX[o] = (bf16)f2bf(wx[src]); } }
}

constexpr int LRU_XC32 = 0, LRU_XCB = 32768, LRU_AA = 50176, LRU_SEG = 82944, LRU_CARRY = 87040;
__device__ __forceinline__ float gelu_tanh(float x) { const float y = 0.7978845608028654f * (x + 0.044715f * x * x * x); const float e = fexp(2.f * y); return x * (1.f - frcp(1.f + e)); }
template <bool FINAL>
__device__ __forceinline__ void lru_unit(const Ctx& C, const InRef& I, int L, int unit, bf16* Ydst) {
    const int g = unit & 7, chunk = (unit >> 3) & (LRU_NCH - 1), b = unit >> 10;
    const int tid = C.tid, lane = C.lane, wid = C.wave;
    const size_t tokbase = (size_t)b * SEQ; const int t0 = chunk * LRU_TC;
    LAS float* XC32 = (LAS float*)(C.lds + LRU_XC32); LAS unsigned char* XCB = C.lds + LRU_XCB; LAS float* AA = (LAS float*)(C.lds + LRU_AA);
    LAS f32x2* SEG = (LAS f32x2*)(C.lds + LRU_SEG); LAS float* CARRY = (LAS float*)(C.lds + LRU_CARRY);
    const bf16* BX = (const bf16*)(C.ws + WS_BX);
    const int seg = tid >> 7, cl = tid & 127, c = g * 128 + cl;
    bf16x8 wbr[8], wbx[8];
    { const int cb2 = wid & 3, r32 = lane & 31, hh = lane >> 5;
      const bf16* WLA = (const bf16*)(C.ws + WS_WLA) + (size_t)(g * 128 + cb2 * 32 + r32) * 128 + hh * 8;
      const bf16* WLX = (const bf16*)(C.ws + WS_WLX) + (size_t)(g * 128 + cb2 * 32 + r32) * 128 + hh * 8;
#pragma unroll
      for (int ks = 0; ks < 8; ++ks) { wbr[ks] = *(const bf16x8*)(WLA + ks * 16); wbx[ks] = *(const bf16x8*)(WLX + ks * 16); } }
    f32x2* LSUM = (f32x2*)(C.ws + WS_LSUM);
    unsigned short bgv[16];
    if constexpr (FINAL) {
        const bf16* BG = (const bf16*)(C.ws + WS_BG) + (tokbase + t0 + seg * 16) * 1024 + c;
#pragma unroll
        for (int i = 0; i < 16; ++i) bgv[i] = BG[(size_t)i * 1024];
        const int per = (chunk + 3) >> 2, klo = seg * per, khi = (klo + per < chunk) ? klo + per : chunk;
        float A = 1.f, H = 0.f; const f32x2* lp = LSUM + (size_t)(b * LRU_NCH) * 1024 + c;
#pragma unroll 8
        for (int k = klo; k < khi; ++k) { const f32x2 v = lp[(size_t)k * 1024]; H = v[0] * H + v[1]; A *= v[0]; }
        ((LAS f32x2*)(C.lds + LRU_CARRY + 512))[seg * 128 + cl] = (f32x2){A, H};
    }
    {
        const int tr = tid >> 3, cb = tid & 7, c0 = g * 128 + cb * 16;
        const float* cw = I.in(7) + (size_t)L * 4 * 1024 + c0; const float* cbp = I.in(8) + (size_t)L * 1024 + c0;
        u32x4 xin[4][2]; f32x4 wt[4][4], bia[4]; float msk[4];
#pragma unroll
        for (int tap = 0; tap < 4; ++tap) { const int sq = t0 + tr - 3 + tap; msk[tap] = sq < 0 ? 0.f : 1.f; const bf16* xp = BX + (tokbase + (sq < 0 ? 0 : sq)) * 1024 + c0;
            xin[tap][0] = *(const u32x4*)xp; xin[tap][1] = *(const u32x4*)(xp + 8);
#pragma unroll
            for (int q = 0; q < 4; ++q) wt[tap][q] = *(const f32x4*)(cw + tap * 1024 + 4 * q); }
#pragma unroll
        for (int q = 0; q < 4; ++q) bia[q] = *(const f32x4*)(cbp + 4 * q);
        __builtin_amdgcn_sched_barrier(0);
        float acc[16];
#pragma unroll
        for (int q = 0; q < 4; ++q) { acc[4 * q] = bia[q][0]; acc[4 * q + 1] = bia[q][1]; acc[4 * q + 2] = bia[q][2]; acc[4 * q + 3] = bia[q][3]; }
#pragma unroll
        for (int tap = 0; tap < 4; ++tap) { const u32x4 x0 = xin[tap][0], x1 = xin[tap][1]; const float mk = msk[tap];
            const float xv[16] = {bflo(x0.x), bfhi(x0.x), bflo(x0.y), bfhi(x0.y), bflo(x0.z), bfhi(x0.z), bflo(x0.w), bfhi(x0.w),
                                  bflo(x1.x), bfhi(x1.x), bflo(x1.y), bfhi(x1.y), bflo(x1.z), bfhi(x1.z), bflo(x1.w), bfhi(x1.w)};
#pragma unroll
            for (int q = 0; q < 4; ++q) { const f32x4 w = wt[tap][q] * mk;
                acc[4 * q] += xv[4 * q] * w[0]; acc[4 * q + 1] += xv[4 * q + 1] * w[1]; acc[4 * q + 2] += xv[4 * q + 2] * w[2]; acc[4 * q + 3] += xv[4 * q + 3] * w[3]; } }
#pragma unroll
        for (int q = 0; q < 4; ++q) *(LAS f32x4*)(XC32 + tr * 128 + cb * 16 + 4 * q) = (f32x4){acc[4 * q], acc[4 * q + 1], acc[4 * q + 2], acc[4 * q + 3]};
        u32x4 p0, p1;
        p0.x = pk2(acc[0], acc[1]); p0.y = pk2(acc[2], acc[3]); p0.z = pk2(acc[4], acc[5]); p0.w = pk2(acc[6], acc[7]);
        p1.x = pk2(acc[8], acc[9]); p1.y = pk2(acc[10], acc[11]); p1.z = pk2(acc[12], acc[13]); p1.w = pk2(acc[14], acc[15]);
        *(LAS u32x4*)(XCB + tr * 272 + cb * 32) = p0; *(LAS u32x4*)(XCB + tr * 272 + cb * 32 + 16) = p1;
    }
    __syncthreads();
    {
        if constexpr (FINAL) {
            if (tid < 128) { float hin = 0.f; const LAS f32x2* LB = (const LAS f32x2*)(C.lds + LRU_CARRY + 512);
#pragma unroll
                for (int sg = 0; sg < 4; ++sg) { const f32x2 v = LB[sg * 128 + tid]; hin = v[0] * hin + v[1]; }
                CARRY[tid] = hin; } }
        const int tb = wid >> 2, cb2 = wid & 3, r32 = lane & 31, hh = lane >> 5;
        f32x16 accr = {}, accx = {};
#pragma unroll
        for (int ks = 0; ks < 8; ++ks) {
            const bf16x8 a = *(const LAS bf16x8*)(XCB + (tb * 32 + r32) * 272 + (ks * 16 + hh * 8) * 2);
            accr = __builtin_amdgcn_mfma_f32_32x32x16_bf16(a, wbr[ks], accr, 0, 0, 0);
            accx = __builtin_amdgcn_mfma_f32_32x32x16_bf16(a, wbx[ks], accx, 0, 0, 0);
        }
        const int cl = cb2 * 32 + r32, c = g * 128 + cl;
        const float ba = I.in(10)[(size_t)L * 1024 + c], bxx = I.in(12)[(size_t)L * 1024 + c], lam = I.in(13)[(size_t)L * 1024 + c];
        const float lsl = flog_sigmoid(lam);
#pragma unroll
        for (int r = 0; r < 16; ++r) {
            const int t = tb * 32 + (r & 3) + 8 * (r >> 2) + 4 * hh;
            const float rr = fast_sigmoid(accr[r] + ba), gi = fast_sigmoid(accx[r] + bxx);
            const float la2 = (8.0f * LOG2E) * rr * lsl;
            const float a = __builtin_amdgcn_exp2f(la2), mult = __builtin_amdgcn_sqrtf(fmaxf(1.f - a * a, 0.f));
            const float xcv = XC32[t * 128 + cl];
            const float uval = mult * (gi * xcv);
            AA[t * 128 + cl] = a; XC32[t * 128 + cl] = uval;
            if constexpr (!FINAL) ((unsigned*)(C.ws + WS_AU))[(tokbase + t0 + t) * 1024 + c] = f2bf(la2) | (f2bf(uval) << 16);
        }
    }
    __syncthreads();
    {
        float Ap = 1.f, H = 0.f;
#pragma unroll
        for (int i = 0; i < 16; ++i) { const int t = seg * 16 + i; const float a = AA[t * 128 + cl], u = XC32[t * 128 + cl]; H = a * H + u; Ap *= a; }
        SEG[seg * 128 + cl] = (f32x2){Ap, H};
    }
    __syncthreads();
    if constexpr (!FINAL) {
        if (tid < 128) { float A = 1.f, H = 0.f;
#pragma unroll
            for (int s = 0; s < 4; ++s) { const f32x2 v = SEG[s * 128 + cl]; H = v[0] * H + v[1]; A *= v[0]; }
            LSUM[(size_t)(b * LRU_NCH + chunk) * 1024 + c] = (f32x2){A, H}; }
    } else {
        float h = CARRY[cl];
        for (int s = 0; s < seg; ++s) { const f32x2 v = SEG[s * 128 + cl]; h = v[0] * h + v[1]; }
        bf16* YB = Ydst + (tokbase + t0 + seg * 16) * 3072 + c;
#pragma unroll
        for (int i = 0; i < 16; ++i) { const int t = seg * 16 + i; h = AA[t * 128 + cl] * h + XC32[t * 128 + cl];
            YB[(size_t)i * 3072] = (bf16)f2bf(gelu_tanh(bflo((unsigned)bgv[i])) * h); }
    }
    __syncthreads();
}

__device__ __forceinline__ void lru_final_unit(const Ctx& C, int unit, unsigned char* Ydst) {
    const int g = unit & 7, chunk = (unit >> 3) & (LRU_NCH - 1), b = unit >> 10;
    const int tid = C.tid, seg = tid >> 7, cl = tid & 127, c = g * 128 + cl;
    const size_t tokbase = (size_t)b * SEQ; const int t0 = chunk * LRU_TC;
    const size_t row0 = tokbase + t0 + seg * 16;
    const unsigned* AU = (const unsigned*)(C.ws + WS_AU) + row0 * 1024 + c;
    const bf16* BG = (const bf16*)(C.ws + WS_BG) + row0 * 1024 + c;
    unsigned au[16]; unsigned short bgv[16];
#pragma unroll
    for (int i = 0; i < 16; ++i) { au[i] = AU[(size_t)i * 1024]; bgv[i] = BG[(size_t)i * 1024]; }
    LAS f32x2* SEG = (LAS f32x2*)(C.lds + LRU_SEG); LAS f32x2* LB = (LAS f32x2*)(C.lds + LRU_CARRY + 512);
    { const f32x2* LSUM = (const f32x2*)(C.ws + WS_LSUM);
      const int per = (chunk + 3) >> 2, klo = seg * per, khi = (klo + per < chunk) ? klo + per : chunk;
      float A = 1.f, H = 0.f; const f32x2* lp = LSUM + (size_t)(b * LRU_NCH) * 1024 + c;
#pragma unroll 8
      for (int k = klo; k < khi; ++k) { const f32x2 v = lp[(size_t)k * 1024]; H = v[0] * H + v[1]; A *= v[0]; }
      LB[seg * 128 + cl] = (f32x2){A, H}; }
    float av[16], uv[16];
    { float Ap = 1.f, H = 0.f;
#pragma unroll
      for (int i = 0; i < 16; ++i) { av[i] = __builtin_amdgcn_exp2f(bflo(au[i])); uv[i] = bfhi(au[i]); H = av[i] * H + uv[i]; Ap *= av[i]; }
      SEG[seg * 128 + cl] = (f32x2){Ap, H}; }
    __syncthreads();
    float h = 0.f;
#pragma unroll
    for (int sg = 0; sg < 4; ++sg) { const f32x2 v = LB[sg * 128 + cl]; h = v[0] * h + v[1]; }
    for (int sg = 0; sg < seg; ++sg) { const f32x2 v = SEG[sg * 128 + cl]; h = v[0] * h + v[1]; }
    unsigned char* YB = Ydst + row0 * 3072 + c;
#pragma unroll
    for (int i = 0; i < 16; ++i) { h = av[i] * h + uv[i]; const float y8 = __builtin_amdgcn_fmed3f(8.f * gelu_tanh(bflo((unsigned)bgv[i])) * h, -448.f, 448.f); YB[(size_t)i * 3072] = (unsigned char)__builtin_amdgcn_cvt_pk_fp8_f32(y8, y8, 0, false); }
    __syncthreads();
}

__device__ __forceinline__ void kmax_phase(const Ctx& C, int L) {
    const bf16* KC = (const bf16*)(C.ws + WS_KC); LAS float* red = (LAS float*)(C.lds + 120 * 1024);
    const int lane = C.lane;
    for (int rb = C.bid; rb < M / 64; rb += C.G) {
        float mx = 0.f;
#pragma unroll
        for (int r = 0; r < 8; ++r) { const bf16* kp = KC + (size_t)(rb * 64 + C.wave * 8 + r) * 1024 + 16 * lane;
            const u32x4 a = *(const u32x4*)kp, b = *(const u32x4*)(kp + 8); float q = 0.f;
#pragma unroll
            for (int i = 0; i < 4; ++i) { q += bflo(a[i]) * bflo(a[i]) + bfhi(a[i]) * bfhi(a[i]); q += bflo(b[i]) * bflo(b[i]) + bfhi(b[i]) * bfhi(b[i]); }
            q += __shfl_xor(q, 1); q += __shfl_xor(q, 2); q += __shfl_xor(q, 4); mx = fmaxf(mx, q); }
        __syncthreads();
        if ((lane & 7) == 0) red[C.wave * 8 + (lane >> 3)] = mx;
        __syncthreads();
        if (C.tid < 8) { float v = red[C.tid];
#pragma unroll
            for (int w = 1; w < 8; ++w) v = fmaxf(v, red[w * 8 + C.tid]);
            const int b = (rb * 64) / SEQ;
            __hip_atomic_fetch_max((unsigned*)(C.ctl + CW_KMAX + 16 * L + b * 8 + C.tid), __builtin_bit_cast(unsigned, v), RLX_AGENT); }
    }
}

constexpr int AT_KT = 0, AT_KPITCH = 272, AT_KBYTES = 64 * 272, AT_VT = 2 * AT_KBYTES, AT_VPITCH = 144, AT_VBYTES = 128 * 144, AT_CK = AT_VT + 2 * AT_VBYTES, AT_TAB = AT_CK + 512;
#define MFMA32(a, b, c) __builtin_amdgcn_mfma_f32_32x32x16_bf16((a), (b), (c), 0, 0, 0)
template <int MODE>
__device__ __forceinline__ void attn_unit(const Ctx& C, const InRef& I, int L, int b, int h, int qb, unsigned char* Odst) {
    constexpr int KS = MODE == 0 ? 4 : 8, QB = MODE == 0 ? 128 : 256;
    const int tid = C.tid, wid = C.wave, lane = C.lane, qi = lane & 31, hh = lane >> 5;
    const int cw = MODE == 0 ? (wid & 1) : 0, qg = MODE == 0 ? (wid >> 1) : wid;
    bf16* Q = (bf16*)(C.ws + (MODE == 0 ? WS_QA : WS_QC));
    const bf16* K = (const bf16*)(C.ws + (MODE == 0 ? WS_KA : WS_KC));
    const bf16* VT = (const bf16*)(C.ws + WS_VT) + (size_t)(MODE == 0 ? 0 : 1024) * M;
    const float* CUM2 = (const float*)(C.ws + WS_CUM2) + (size_t)(b * 8 + h) * SEQ;
    const size_t tokbase = (size_t)b * SEQ;
    const int q0 = qb * QB + qg * 32, qpos = q0 + qi;
    LAS unsigned char* lds = C.lds;
    LAS float* TAB = (LAS float*)(lds + AT_TAB);
    float c31 = 0.f, cq2 = 0.f, lam = 0.f;
    const float lam_init = L == 0 ? 0.2f : 0.35550907f;
    if constexpr (MODE == 0) {
        const float* rel = I.in(6);
        if (tid < 128) { const int n = tid; int bk = n;
            if (n >= 16) { bk = 16 + (int)(__builtin_amdgcn_logf((float)n * 0.0625f) * (16.f / 3.f));     bk = bk > 31 ? 31 : bk; }
            TAB[n] = rel[bk * 8 + h] * LOG2E; }
        c31 = rel[31 * 8 + h] * LOG2E;
        const float* lv = I.in(4) + (size_t)L * 256;
        const float s1 = wave_sum(lv[lane] * lv[64 + lane]), s2 = wave_sum(lv[128 + lane] * lv[192 + lane]);
        lam = fexp(s1) - fexp(s2) + lam_init;
    } else { cq2 = CUM2[qpos]; }
    bf16x8 qf[KS];
    { const bf16* qp = Q + (tokbase + qpos) * 1024 + h * 128 + cw * 64 + hh * 8;
#pragma unroll
      for (int ks = 0; ks < KS; ++ks) qf[ks] = *(const bf16x8*)(qp + ks * 16); }
    f32x16 o[4]; float mrun = -1e30f, lrun = 0.f;
#pragma unroll
    for (int d = 0; d < 4; ++d) o[d] = (f32x16){};
    const int NT = (qb + 1) * (QB / 64);
    float B0 = 0.f; bool wdone = false;
    if constexpr (MODE == 1) {
        float ssq = 0.f;
#pragma unroll
        for (int ks = 0; ks < KS; ++ks)
#pragma unroll
            for (int j = 0; j < 8; ++j) { const float v = __builtin_bit_cast(float, (unsigned)(unsigned short)qf[ks][j] << 16); ssq += v * v; }
        ssq += __shfl_xor(ssq, 32);
#pragma unroll
        for (int of = 1; of < 32; of <<= 1) ssq = fmaxf(ssq, __shfl_xor(ssq, of));
        const float kmax2 = __builtin_bit_cast(float, __hip_atomic_load((unsigned*)(C.ctl + CW_KMAX + 16 * L + b * 8 + h), RLX_AGENT));
        B0 = __builtin_amdgcn_sqrtf(ssq * kmax2) * 1.0001f + 1.0f;
    }
    const int krow = tid >> 4, kch = tid & 15, vrow = tid >> 3, vch = tid & 7;
    const char* Ku = (const char*)(K + tokbase * 1024 + h * 128); const unsigned koff = (unsigned)(krow * 1024 + kch * 8) * 2u;
    const char* Vu = (const char*)(VT + (size_t)(h * 128) * M + tokbase); const unsigned voff = (unsigned)(vrow * M + vch * 8) * 2u;
    u32x4 sk0, sk1, sv0, sv1; float sck = 0.f;
#define AT_LOAD(k0_) do { const char* kp_ = Ku + (size_t)(k0_) * 2048; const char* vp2_ = Vu + (size_t)(k0_) * 2; sk0 = *(const u32x4*)(kp_ + koff); sk1 = *(const u32x4*)(kp_ + 32 * 2048 + koff); \
        sv0 = *(const u32x4*)(vp2_ + voff); sv1 = *(const u32x4*)(vp2_ + (size_t)64 * M * 2 + voff); if (MODE == 1 && tid < 64) sck = CUM2[(k0_) + tid]; } while (0)
    AT_LOAD(MODE == 1 ? (NT - 1) * 64 : 0);
    const int kr = (qi & 19) | ((qi & 4) << 1) | ((qi & 8) >> 1);
    for (int it = 0; it < NT; ++it) {
        const int t = MODE == 1 ? NT - 1 - it : it;
        const int buf = it & 1, k0 = t * 64;
        LAS unsigned char* kt = lds + AT_KT + buf * AT_KBYTES; LAS unsigned char* vt = lds + AT_VT + buf * AT_VBYTES; LAS float* ck = (LAS float*)(lds + AT_CK + buf * 256);
        *(LAS u32x4*)(kt + krow * AT_KPITCH + kch * 16) = sk0; *(LAS u32x4*)(kt + (krow + 32) * AT_KPITCH + kch * 16) = sk1;
        *(LAS u32x4*)(vt + vrow * AT_VPITCH + vch * 16) = sv0; *(LAS u32x4*)(vt + (vrow + 64) * AT_VPITCH + vch * 16) = sv1;
        if (MODE == 1 && tid < 64) ck[tid] = sck;
        __syncthreads();
        if constexpr (MODE == 1) {
            if (it > 0) { const LAS int* fl = (const LAS int*)(lds + AT_TAB) + ((it - 1) & 1) * 8;
                if (fl[0] & fl[1] & fl[2] & fl[3] & fl[4] & fl[5] & fl[6] & fl[7]) break; }
        }
        if (it + 1 < NT) AT_LOAD(MODE == 1 ? k0 - 64 : k0 + 64);
        bool act = (k0 <= q0);
        if constexpr (MODE == 1) {
            if (act && !wdone) { const float D = __shfl(cq2, 0) - ck[63]; float mmin = mrun;
#pragma unroll
                for (int of = 1; of < 64; of <<= 1) mmin = fminf(mmin, __shfl_xor(mmin, of));
                if (B0 + D < mmin - 40.f) wdone = true; }
            if (lane == 0) ((LAS int*)(lds + AT_TAB))[(it & 1) * 8 + wid] = wdone ? 1 : 0;
            act = act && !wdone;
        }
        if (act) {
            f32x16 s[2]; s[0] = (f32x16){}; s[1] = (f32x16){};
#pragma unroll
            for (int ks = 0; ks < KS; ++ks) {
                const LAS unsigned char* ap = kt + kr * AT_KPITCH + (cw * 64 + ks * 16 + hh * 8) * 2;
                const bf16x8 a0 = *(const LAS bf16x8*)ap, a1 = *(const LAS bf16x8*)(ap + 32 * AT_KPITCH);
                s[0] = MFMA32(a0, qf[ks], s[0]); s[1] = MFMA32(a1, qf[ks], s[1]);
            }
            if constexpr (MODE == 0) {
                if (k0 + 63 + 128 > q0) {
#pragma unroll
                    for (int kb = 0; kb < 2; ++kb)
#pragma unroll
                        for (int r = 0; r < 16; ++r) { const int key = k0 + kb * 32 + 16 * (r >> 3) + 8 * hh + (r & 7), dist = qpos - key;
                            const int di = dist < 0 ? 0 : (dist > 127 ? 127 : dist);
                            const float v = s[kb][r] + TAB[di]; s[kb][r] = dist < 0 ? -__builtin_inff() : v; }
                } else {
#pragma unroll
                    for (int kb = 0; kb < 2; ++kb)
#pragma unroll
                        for (int r = 0; r < 16; ++r) s[kb][r] += c31;
                }
            } else {
#pragma unroll
                for (int kb = 0; kb < 2; ++kb)
#pragma unroll
                    for (int r = 0; r < 16; ++r) { const int kl = kb * 32 + 16 * (r >> 3) + 8 * hh + (r & 7);
                        const float v = s[kb][r] + (cq2 - ck[kl]); s[kb][r] = (k0 + kl > qpos) ? -__builtin_inff() : v; }
            }
            float mx = s[0][0];
#pragma unroll
            for (int r = 1; r < 16; ++r) mx = fmaxf(mx, s[0][r]);
#pragma unroll
            for (int r = 0; r < 16; ++r) mx = fmaxf(mx, s[1][r]);
            mx = fmaxf(mx, __shfl_xor(mx, 32));
            const float mnew = fmaxf(mrun, mx), alpha = __builtin_amdgcn_exp2f(mrun - mnew);
            mrun = mnew;
            float ps = 0.f;
#pragma unroll
            for (int kb = 0; kb < 2; ++kb)
#pragma unroll
                for (int r = 0; r < 16; ++r) { const float p = __builtin_amdgcn_exp2f(s[kb][r] - mnew); s[kb][r] = p; ps += p; }
            lrun = lrun * alpha + ps;
            if (!__all(alpha == 1.f)) {
#pragma unroll
                for (int d = 0; d < 4; ++d)
#pragma unroll
                    for (int r = 0; r < 16; ++r) o[d][r] *= alpha;
            }
            bf16x8 pf[2][2];
#pragma unroll
            for (int kb = 0; kb < 2; ++kb)
#pragma unroll
                for (int s2 = 0; s2 < 2; ++s2) { u32x4 w;
                    w.x = cvtpk(s[kb][8 * s2 + 0], s[kb][8 * s2 + 1]); w.y = cvtpk(s[kb][8 * s2 + 2], s[kb][8 * s2 + 3]);
                    w.z = cvtpk(s[kb][8 * s2 + 4], s[kb][8 * s2 + 5]); w.w = cvtpk(s[kb][8 * s2 + 6], s[kb][8 * s2 + 7]);
                    pf[kb][s2] = __builtin_bit_cast(bf16x8, w); }
#pragma unroll
            for (int kb = 0; kb < 2; ++kb)
#pragma unroll
                for (int s2 = 0; s2 < 2; ++s2)
#pragma unroll
                    for (int d = 0; d < 4; ++d) {
                        const bf16x8 a = *(const LAS bf16x8*)(vt + (d * 32 + qi) * AT_VPITCH + (kb * 32 + s2 * 16 + hh * 8) * 2);
                        o[d] = MFMA32(a, pf[kb][s2], o[d]);
                    }
        }
    }
#undef AT_LOAD
    unsigned char* Op = Odst + (tokbase + qpos) * 3072 + h * 128 + 4 * hh;
    const float ltot = lrun + __shfl_xor(lrun, 32);
    if constexpr (MODE == 0) {
        LAS float* X = (LAS float*)(lds + qg * 16384);
        __syncthreads();
        if (cw == 1) { const float i1 = lam * frcp(ltot);
#pragma unroll
            for (int d = 0; d < 4; ++d)
#pragma unroll
                for (int r = 0; r < 16; ++r) X[(d * 16 + r) * 64 + lane] = o[d][r] * i1; }
        __syncthreads();
        if (cw == 0) {
            const float i0 = frcp(ltot); float ss = 0.f;
#pragma unroll
            for (int d = 0; d < 4; ++d)
#pragma unroll
                for (int r = 0; r < 16; ++r) { const float y = o[d][r] * i0 - X[(d * 16 + r) * 64 + lane]; o[d][r] = y; ss += y * y; }
            ss += __shfl_xor(ss, 32);
            const float rs = frsq(ss * (1.f / 128.f) + LN_EPS) * (1.f - lam_init);
            const float* sub = I.in(5) + (size_t)L * 128 + 4 * hh;
#pragma unroll
            for (int d = 0; d < 4; ++d)
#pragma unroll
                for (int g4 = 0; g4 < 4; ++g4) { const f32x4 w = *(const f32x4*)(sub + d * 32 + 8 * g4);
                    *(unsigned*)(Op + d * 32 + 8 * g4) = pack4_fp8(o[d][4 * g4] * rs * w[0], o[d][4 * g4 + 1] * rs * w[1], o[d][4 * g4 + 2] * rs * w[2], o[d][4 * g4 + 3] * rs * w[3], 8.f); }
        }
    } else {
        const float i0 = frcp(ltot);
#pragma unroll
        for (int d = 0; d < 4; ++d)
#pragma unroll
            for (int g4 = 0; g4 < 4; ++g4) {
                *(unsigned*)(Op + d * 32 + 8 * g4) = pack4_fp8(o[d][4 * g4] * i0, o[d][4 * g4 + 1] * i0, o[d][4 * g4 + 2] * i0, o[d][4 * g4 + 3] * i0, 8.f); }
    }
}

__device__ __forceinline__ float max3f(float a, float b, float c) { float r; asm("v_max3_f32 %0, %1, %2, %3" : "=v"(r) : "v"(a), "v"(b), "v"(c)); return r; }
__device__ __forceinline__ void attn_diff_unit(const Ctx& C, const InRef& I, int L, int b, int h, int qb, unsigned char* Odst) {
    const int tid = C.tid, wid = C.wave, lane = C.lane, qi = lane & 31, hh = lane >> 5;
    const int cw = wid & 1, qg = wid >> 1;
    const bf16* Q = (const bf16*)(C.ws + WS_QA); const bf16* K = (const bf16*)(C.ws + WS_KA); const bf16* VT = (const bf16*)(C.ws + WS_VT);
    const size_t tokbase = (size_t)b * SEQ;
    const int q0 = qb * 128 + qg * 32, qpos = q0 + qi;
    LAS unsigned char* lds = C.lds;
    LAS float* TAB = (LAS float*)(lds + AT_TAB);
    const float lam_init = L == 0 ? 0.2f : 0.35550907f;
    const float* rel = I.in(6);
    if (tid < 128) { const int n = tid; int bk = n;
        if (n >= 16) { bk = 16 + (int)(__builtin_amdgcn_logf((float)n * 0.0625f) * (16.f / 3.f));     bk = bk > 31 ? 31 : bk; }
        TAB[n] = (rel[bk * 8 + h] - rel[31 * 8 + h]) * LOG2E; }
    const float c31 = rel[31 * 8 + h] * LOG2E;
    float lam;
    { const float* lv = I.in(4) + (size_t)L * 256;
      const float s1 = wave_sum(lv[lane] * lv[64 + lane]), s2 = wave_sum(lv[128 + lane] * lv[192 + lane]);
      lam = fexp(s1) - fexp(s2) + lam_init; }
    LAS unsigned char* qlds = lds + AT_TAB + 512 + wid * 4096 + lane * 16;
    { const bf16* qp = Q + (tokbase + qpos) * 1024 + h * 128 + cw * 64 + hh * 8;
#pragma unroll
      for (int ks = 0; ks < 4; ++ks) *(LAS bf16x8*)(qlds + ks * 1024) = *(const bf16x8*)(qp + ks * 16); }
    f32x16 o[4]; float mrun = -1e30f, lrun = 0.f;
#pragma unroll
    for (int d = 0; d < 4; ++d) o[d] = (f32x16){};
    const int NT = (qb + 1) * 2;
    const int krow = tid >> 4, kch = tid & 15, vrow = tid >> 3, vch = tid & 7;
    const char* Ku = (const char*)(K + tokbase * 1024 + h * 128); const unsigned koff = (unsigned)(krow * 1024 + kch * 8) * 2u;
    const char* Vu = (const char*)(VT + (size_t)(h * 128) * M + tokbase); const unsigned voff = (unsigned)(vrow * M + vch * 8) * 2u;
    const int kr = (qi & 19) | ((qi & 4) << 1) | ((qi & 8) >> 1);
    const int kaoff = kr * AT_KPITCH + (cw * 64 + hh * 8) * 2, vaoff = qi * AT_VPITCH + hh * 16;
    u32x4 sk0, sk1, sv0, sv1;
#define DA_LOADK(k0_) do { const char* kp_ = Ku + (size_t)(k0_) * 2048; sk0 = *(const u32x4*)(kp_ + koff); sk1 = *(const u32x4*)(kp_ + 32 * 2048 + koff); } while (0)
#define DA_LOADV(k0_) do { const char* vp2_ = Vu + (size_t)(k0_) * 2; sv0 = *(const u32x4*)(vp2_ + voff); sv1 = *(const u32x4*)(vp2_ + (size_t)64 * M * 2 + voff); } while (0)
#define DA_WRITEK(bf_) do { LAS unsigned char* kt_ = lds + AT_KT + (bf_) * AT_KBYTES; *(LAS u32x4*)(kt_ + krow * AT_KPITCH + kch * 16) = sk0; *(LAS u32x4*)(kt_ + (krow + 32) * AT_KPITCH + kch * 16) = sk1; } while (0)
#define DA_WRITEV(bf_) do { LAS unsigned char* vt_ = lds + AT_VT + (bf_) * AT_VBYTES; *(LAS u32x4*)(vt_ + vrow * AT_VPITCH + vch * 16) = sv0; *(LAS u32x4*)(vt_ + (vrow + 64) * AT_VPITCH + vch * 16) = sv1; } while (0)
#define DA_QK(S0, S1, MU, bf_) do { const LAS unsigned char* ap_ = lds + AT_KT + (bf_) * AT_KBYTES + kaoff; MU = cref; \
        _Pragma("unroll") for (int ks = 0; ks < 4; ++ks) { const bf16x8 a0 = *(const LAS bf16x8*)(ap_ + ks * 32), a1 = *(const LAS bf16x8*)(ap_ + ks * 32 + 32 * AT_KPITCH); \
            const bf16x8 qk_ = *(const LAS bf16x8*)(qlds + ks * 1024); S0 = MFMA32(a0, qk_, ks ? S0 : CI); S1 = MFMA32(a1, qk_, ks ? S1 : CI); } } while (0)
#define SB() __builtin_amdgcn_sched_barrier(0)
#define DA_RD1(dst, addr, off) asm volatile("ds_read_b128 %0, %1 offset:%2" : "=v"(dst) : "v"(addr), "i"(off) : "memory")
#define DA_RD4(a0, a1, a2, a3, addr, off) do { DA_RD1(a0, addr, (off)); DA_RD1(a1, addr, (off) + 32 * AT_VPITCH); DA_RD1(a2, addr, (off) + 64 * AT_VPITCH); DA_RD1(a3, addr, (off) + 96 * AT_VPITCH); } while (0)
#define DA_SMPV(S0, S1, MU, k0_, bf_) do { \
        float mx; \
        if ((k0_) + 63 + 113 > q0) {   \
            int qrel_ = qpos - 8 * hh - (k0_); asm volatile("" : "+v"(qrel_));     \
            _Pragma("unroll") for (int r = 0; r < 16; ++r) { const int d0 = qrel_ - (16 * (r >> 3) + (r & 7)), d1 = d0 - 32; \
                const float v0 = S0[r] + TAB[d0 < 0 ? 0 : (d0 > 127 ? 127 : d0)], v1 = S1[r] + TAB[d1 < 0 ? 0 : (d1 > 127 ? 127 : d1)]; \
                S0[r] = d0 < 0 ? -__builtin_inff() : v0; S1[r] = d1 < 0 ? -__builtin_inff() : v1; } \
            } \
        mx = fmaxf(S0[0], S1[0]); \
        _Pragma("unroll") for (int r = 1; r < 16; ++r) mx = max3f(mx, S0[r], S1[r]); \
        mx = fmaxf(mx, __shfl_xor(mx, 32)) + MU;            \
          \
        const bool keep_ = __all(mx - mrun <= 8.f); \
        const float mnew = keep_ ? mrun : fmaxf(mrun, mx), alpha = keep_ ? 1.f : __builtin_amdgcn_exp2f(mrun - mnew), sh = MU - mnew; mrun = mnew; \
        if (!__all(sh == 0.f)) { _Pragma("unroll") for (int r = 0; r < 16; ++r) { S0[r] += sh; S1[r] += sh; } }     \
        if (!keep_) { cref = mrun; _Pragma("unroll") for (int r = 0; r < 16; ++r) CI[r] = c31 - cref; } \
        float ps = 0.f; \
        _Pragma("unroll") for (int r = 0; r < 16; ++r) { S0[r] = __builtin_amdgcn_exp2f(S0[r]); S1[r] = __builtin_amdgcn_exp2f(S1[r]); ps += S0[r] + S1[r]; } \
        lrun = lrun * alpha + ps; \
        if (!keep_) { _Pragma("unroll") for (int d = 0; d < 4; ++d) _Pragma("unroll") for (int r = 0; r < 16; ++r) o[d][r] *= alpha; } \
        bf16x8 pf[4]; \
        _Pragma("unroll") for (int s2 = 0; s2 < 2; ++s2) { u32x4 w0, w1; \
            w0.x = cvtpk(S0[8 * s2 + 0], S0[8 * s2 + 1]); w0.y = cvtpk(S0[8 * s2 + 2], S0[8 * s2 + 3]); w0.z = cvtpk(S0[8 * s2 + 4], S0[8 * s2 + 5]); w0.w = cvtpk(S0[8 * s2 + 6], S0[8 * s2 + 7]); \
            w1.x = cvtpk(S1[8 * s2 + 0], S1[8 * s2 + 1]); w1.y = cvtpk(S1[8 * s2 + 2], S1[8 * s2 + 3]); w1.z = cvtpk(S1[8 * s2 + 4], S1[8 * s2 + 5]); w1.w = cvtpk(S1[8 * s2 + 6], S1[8 * s2 + 7]); \
            pf[s2] = __builtin_bit_cast(bf16x8, w0); pf[2 + s2] = __builtin_bit_cast(bf16x8, w1); } \
          \
        { const unsigned va_ = (unsigned)(unsigned long)(lds + AT_VT + (bf_) * AT_VBYTES + vaoff); bf16x8 f0, f1, f2, f3, g0, g1, g2, g3; \
          DA_RD4(f0, f1, f2, f3, va_, 0); DA_RD4(g0, g1, g2, g3, va_, 32); \
          asm volatile("s_waitcnt lgkmcnt(4)" ::: "memory"); SB(); \
          o[0] = MFMA32(f0, pf[0], o[0]); o[1] = MFMA32(f1, pf[0], o[1]); o[2] = MFMA32(f2, pf[0], o[2]); o[3] = MFMA32(f3, pf[0], o[3]); SB(); \
          DA_RD4(f0, f1, f2, f3, va_, 64); \
          asm volatile("s_waitcnt lgkmcnt(4)" ::: "memory"); SB(); \
          o[0] = MFMA32(g0, pf[1], o[0]); o[1] = MFMA32(g1, pf[1], o[1]); o[2] = MFMA32(g2, pf[1], o[2]); o[3] = MFMA32(g3, pf[1], o[3]); SB(); \
          DA_RD4(g0, g1, g2, g3, va_, 96); \
          asm volatile("s_waitcnt lgkmcnt(4)" ::: "memory"); SB(); \
          o[0] = MFMA32(f0, pf[2], o[0]); o[1] = MFMA32(f1, pf[2], o[1]); o[2] = MFMA32(f2, pf[2], o[2]); o[3] = MFMA32(f3, pf[2], o[3]); SB(); \
          asm volatile("s_waitcnt lgkmcnt(0)" ::: "memory"); SB(); \
          o[0] = MFMA32(g0, pf[3], o[0]); o[1] = MFMA32(g1, pf[3], o[1]); o[2] = MFMA32(g2, pf[3], o[2]); o[3] = MFMA32(g3, pf[3], o[3]); SB(); } } while (0)
#define DA_STEP(t_, SC0, SC1, MUC, SN0, SN1, MUN) do { const int k0 = (t_) * 64; \
        if ((t_) + 1 < NT) DA_WRITEK(((t_) + 1) & 1); DA_WRITEV((t_) & 1); \
        __syncthreads(); \
        if ((t_) + 2 < NT) DA_LOADK(k0 + 128); if ((t_) + 1 < NT) DA_LOADV(k0 + 64); \
        const bool act_ = k0 <= q0, actn_ = ((t_) + 1 < NT) && (k0 + 64 <= q0); \
        if (actn_) DA_QK(SN0, SN1, MUN, ((t_) + 1) & 1); \
        if (act_) DA_SMPV(SC0, SC1, MUC, k0, (t_) & 1); } while (0)
    f32x16 sa0, sa1, sb0, sb1, CI; float cref = 0.f, mua = 0.f, mub = 0.f;
#pragma unroll
    for (int r = 0; r < 16; ++r) CI[r] = c31;
    DA_LOADK(0); DA_WRITEK(0); DA_LOADK(64); DA_LOADV(0);
    __syncthreads();
    DA_QK(sa0, sa1, mua, 0);
    for (int t = 0; t < NT; t += 2) { DA_STEP(t, sa0, sa1, mua, sb0, sb1, mub); DA_STEP(t + 1, sb0, sb1, mub, sa0, sa1, mua); }
#undef DA_LOADK
#undef DA_LOADV
#undef DA_WRITEK
#undef DA_WRITEV
#undef DA_QK
#undef DA_SMPV
#undef DA_STEP
    unsigned char* Op = Odst + (tokbase + qpos) * 3072 + h * 128 + 4 * hh;
    const float ltot = lrun + __shfl_xor(lrun, 32);
    LAS float* X = (LAS float*)(lds + qg * 16384);
    __syncthreads();
    if (cw == 1) { const float i1 = lam * frcp(ltot);
#pragma unroll
        for (int d = 0; d < 4; ++d)
#pragma unroll
            for (int r = 0; r < 16; ++r) X[(d * 16 + r) * 64 + lane] = o[d][r] * i1; }
    __syncthreads();
    if (cw == 0) {
        const float i0 = frcp(ltot); float ss = 0.f;
#pragma unroll
        for (int d = 0; d < 4; ++d)
#pragma unroll
            for (int r = 0; r < 16; ++r) { const float y = o[d][r] * i0 - X[(d * 16 + r) * 64 + lane]; o[d][r] = y; ss += y * y; }
        ss += __shfl_xor(ss, 32);
        const float rs = frsq(ss * (1.f / 128.f) + LN_EPS) * (1.f - lam_init);
        const float* sub = I.in(5) + (size_t)L * 128 + 4 * hh;
#pragma unroll
        for (int d = 0; d < 4; ++d)
#pragma unroll
            for (int g4 = 0; g4 < 4; ++g4) { const f32x4 w = *(const f32x4*)(sub + d * 32 + 8 * g4);
                *(unsigned*)(Op + d * 32 + 8 * g4) = pack4_fp8(o[d][4 * g4] * rs * w[0], o[d][4 * g4 + 1] * rs * w[1], o[d][4 * g4 + 2] * rs * w[2], o[d][4 * g4 + 3] * rs * w[3], 8.f); }
    }
}

__device__ __forceinline__ void ln_row_store(float (&y)[4][8], const float* gam, const float* bet, float* of32, bf16* ob16, int lane, unsigned char* ob8 = nullptr) {
    float s = 0.f;
#pragma unroll
    for (int j = 0; j < 4; ++j)
#pragma unroll
        for (int i = 0; i < 8; ++i) s += y[j][i];
    const float mean = wave_sum(s) * (1.f / DM); float q = 0.f;
#pragma unroll
    for (int j = 0; j < 4; ++j)
#pragma unroll
        for (int i = 0; i < 8; ++i) { y[j][i] -= mean; q += y[j][i] * y[j][i]; }
    const float rstd = frsq(wave_sum(q) * (1.f / DM) + LN_EPS);
#pragma unroll
    for (int j = 0; j < 4; ++j) { const int e = 512 * j + 8 * lane;
        const f32x4 g0 = *(const f32x4*)(gam + e), g1 = *(const f32x4*)(gam + e + 4), b0 = *(const f32x4*)(bet + e), b1 = *(const f32x4*)(bet + e + 4);
        f32x4 o0, o1;
#pragma unroll
        for (int i = 0; i < 4; ++i) { o0[i] = y[j][i] * rstd * g0[i] + b0[i]; o1[i] = y[j][4 + i] * rstd * g1[i] + b1[i]; }
        if (of32) { *(f32x4*)(of32 + e) = o0; *(f32x4*)(of32 + e + 4) = o1; }
        *(u32x4*)(ob16 + e) = pack8(o0, o1);
        if (ob8) *(u32x2*)(ob8 + e) = pack8_fp8(o0, o1, 1.f); }
}
__device__ __forceinline__ void ln1_phase(const Ctx& C, const InRef& I, int L, int dry) {
    const bf16* YB = (const bf16*)(C.ws + WS_YB); bf16* X1B = (bf16*)(C.ws + (dry ? WS_KC : WS_X1B));
    for (int m = C.gw; m < M; m += C.NGW) {
        float y[4][8]; const bf16* row = YB + (size_t)m * DM;
#pragma unroll
        for (int j = 0; j < 4; ++j) { const u32x4 a = *(const u32x4*)(row + 512 * j + 8 * C.lane);
            y[j][0] = bflo(a.x); y[j][1] = bfhi(a.x); y[j][2] = bflo(a.y); y[j][3] = bfhi(a.y); y[j][4] = bflo(a.z); y[j][5] = bfhi(a.z); y[j][6] = bflo(a.w); y[j][7] = bfhi(a.w); }
        ln_row_store(y, I.in(16) + (size_t)L * DM, I.in(17) + (size_t)L * DM, nullptr, X1B + (size_t)m * DM, C.lane, dry ? (unsigned char*)nullptr : C.ws + WS_X1B8 + (size_t)m * DM);
    }
}

#define TOPK_INS(v_, ls) do { float v__ = (v_); _Pragma("unroll") for (int k_ = 0; k_ < 16; ++k_) { const float hi_ = fmaxf(ls[k_], v__); v__ = fminf(ls[k_], v__); ls[k_] = hi_; } } while (0)
__device__ __forceinline__ float embed_bits(float v, unsigned mask, unsigned payload) { return __builtin_bit_cast(float, (__builtin_bit_cast(unsigned, v) & ~mask) | payload); }
__device__ __forceinline__ unsigned sel16x7(unsigned p0, unsigned p1, unsigned p2, unsigned p3, unsigned i) {
    const unsigned q = i >> 2; unsigned w = p0; w = q == 1 ? p1 : w; w = q == 2 ? p2 : w; w = q == 3 ? p3 : w; return (w >> (8 * (i & 3))) & 0x7Fu;
}
__device__ __forceinline__ void ce_desc(float& a, float& b) { const float hi = fmaxf(a, b), lo = fminf(a, b); a = hi; b = lo; }
__device__ __forceinline__ void bitonic_merge16_desc(float (&v)[16]) {
#pragma unroll
    for (int j = 8; j > 0; j >>= 1)
#pragma unroll
        for (int i = 0; i < 16; ++i) if ((i & j) == 0) ce_desc(v[i], v[i | j]);
}
__device__ __forceinline__ void sort16_desc(float (&v)[16]) {
#pragma unroll
    for (int k = 2; k <= 16; k <<= 1)
#pragma unroll
        for (int j = k >> 1; j > 0; j >>= 1)
#pragma unroll
            for (int i = 0; i < 16; ++i) { const int l = i ^ j; if (l > i) { if ((i & k) == 0) ce_desc(v[i], v[l]); else ce_desc(v[l], v[i]); } }
}
__device__ __forceinline__ void top16_merge_desc(float (&a)[16], const float (&b)[16]) {
#pragma unroll
    for (int i = 0; i < 16; ++i) a[i] = fmaxf(a[i], b[15 - i]);
    bitonic_merge16_desc(a);
}
__device__ __forceinline__ void peer_select_phase(const Ctx& C) {
    const bf16* PQ = (const bf16*)(C.ws + WS_PQ); const bf16* KEYS = (const bf16*)(C.ws + WS_KEYS);
    int* SELI = (int*)(C.ws + WS_SELI); float* SELG = (float*)(C.ws + WS_SELG);
    const int lane = C.lane, qi = lane & 31, hh = lane >> 5;
    for (int wu = C.gw; wu < (M / 32) * 8; wu += C.NGW) {
        const int head = wu & 7, tg = wu >> 3, token = tg * 32 + qi;
        float s12[2][16];
#pragma unroll
        for (int p = 0; p < 2; ++p) {
            f32x16 sc[4];
#pragma unroll
            for (int kb = 0; kb < 4; ++kb) sc[kb] = (f32x16){};
            const bf16* qp = PQ + (size_t)token * 1024 + head * 128 + p * 64 + hh * 8;
            const bf16* kp = KEYS + (size_t)((head * 2 + p) * 128 + qi) * 64 + hh * 8;
#pragma unroll
            for (int ks = 0; ks < 4; ++ks) { const bf16x8 qf = *(const bf16x8*)(qp + ks * 16);
#pragma unroll
                for (int kb = 0; kb < 4; ++kb) { const bf16x8 a = *(const bf16x8*)(kp + (size_t)kb * 32 * 64 + ks * 16); sc[kb] = MFMA32(a, qf, sc[kb]); } }
            float l0[16], l1[16], l2[16], l3[16];
#pragma unroll
            for (int r = 0; r < 16; ++r) { const unsigned n = (unsigned)((r & 3) + 8 * (r >> 2) + 4 * hh);
                l0[r] = embed_bits(sc[0][r], 0x7Fu, n); l1[r] = embed_bits(sc[1][r], 0x7Fu, n + 32u); l2[r] = embed_bits(sc[2][r], 0x7Fu, n + 64u); l3[r] = embed_bits(sc[3][r], 0x7Fu, n + 96u); }
            sort16_desc(l0); sort16_desc(l1); sort16_desc(l2); sort16_desc(l3);
            top16_merge_desc(l0, l1); top16_merge_desc(l2, l3); top16_merge_desc(l0, l2);
            float ps[16];
#pragma unroll
            for (int k = 0; k < 16; ++k) ps[k] = __shfl_xor(l0[k], 32);
            top16_merge_desc(l0, ps);
#pragma unroll
            for (int k = 0; k < 16; ++k) s12[p][k] = l0[k];
        }
        unsigned P1[4], P2[4];
#pragma unroll
        for (int q = 0; q < 4; ++q) { P1[q] = 0u; P2[q] = 0u;
#pragma unroll
            for (int t = 0; t < 4; ++t) { P1[q] |= (__builtin_bit_cast(unsigned, s12[0][4 * q + t]) & 0x7Fu) << (8 * t); P2[q] |= (__builtin_bit_cast(unsigned, s12[1][4 * q + t]) & 0x7Fu) << (8 * t); } }
#define CAND(i, j) embed_bits(s12[0][i] + s12[1][j], 0xFFu, (unsigned)((i) * 16 + (j)))
        float ca[16], cb[16], cc[16], cd[16]; const float NINF = -__builtin_inff();
#pragma unroll
        for (int j = 0; j < 16; ++j) ca[j] = CAND(0, j);
#pragma unroll
        for (int j = 0; j < 8; ++j) cb[j] = CAND(1, j);
#pragma unroll
        for (int j = 0; j < 5; ++j) cb[8 + j] = CAND(2, j);
#pragma unroll
        for (int j = 0; j < 3; ++j) cb[13 + j] = CAND(4, j);
#pragma unroll
        for (int j = 0; j < 4; ++j) cc[j] = CAND(3, j);
        cc[4] = CAND(5, 0); cc[5] = CAND(5, 1); cc[6] = CAND(6, 0); cc[7] = CAND(6, 1); cc[8] = CAND(7, 0); cc[9] = CAND(7, 1);
#pragma unroll
        for (int i = 8; i < 14; ++i) cc[2 + i] = CAND(i, 0);
        cd[0] = CAND(14, 0); cd[1] = CAND(15, 0);
#pragma unroll
        for (int k = 2; k < 16; ++k) cd[k] = NINF;
#undef CAND
        sort16_desc(ca); sort16_desc(cb); sort16_desc(cc); sort16_desc(cd);
        top16_merge_desc(ca, cb); top16_merge_desc(cc, cd); top16_merge_desc(ca, cc);
        float e[16], sum = 0.f; unsigned ti[16];
#pragma unroll
        for (int k = 0; k < 16; ++k) { e[k] = fexp(ca[k] - ca[0]); sum += e[k];
            const unsigned ij = __builtin_bit_cast(unsigned, ca[k]) & 0xFFu; ti[k] = sel16x7(P1[0], P1[1], P1[2], P1[3], ij >> 4) * 128u + sel16x7(P2[0], P2[1], P2[2], P2[3], ij & 15u); }
        const float inv = frcp(sum);
        if (hh == 0) {
#pragma unroll
            for (int q = 0; q < 4; ++q) *(u32x4*)(SELI + (size_t)token * 128 + head * 16 + 4 * q) = (u32x4){ti[4 * q], ti[4 * q + 1], ti[4 * q + 2], ti[4 * q + 3]};
        } else {
#pragma unroll
            for (int q = 0; q < 4; ++q) *(f32x4*)(SELG + (size_t)token * 128 + head * 16 + 4 * q) = (f32x4){e[4 * q] * inv, e[4 * q + 1] * inv, e[4 * q + 2] * inv, e[4 * q + 3] * inv};
        }
    }
}

typedef unsigned u32x3 __attribute__((ext_vector_type(3)));
typedef unsigned u32x6 __attribute__((ext_vector_type(6)));
typedef float f32x32 __attribute__((ext_vector_type(32)));
struct __attribute__((packed, aligned(4))) U3 { unsigned a, b, c; };
__device__ __forceinline__ f32x32 dec32_fp6(const U3 w0, const U3 w1) { u32x6 w; w[0] = w0.a; w[1] = w0.b; w[2] = w0.c; w[3] = w1.a; w[4] = w1.b; w[5] = w1.c; return __builtin_amdgcn_cvt_scalef32_pk32_f32_fp6(w, 1.0f); }
__device__ __forceinline__ float dot32_fp6(const U3 w0, const U3 w1, const float (&x)[2][16]) {
    const f32x32 d = dec32_fp6(w0, w1); float a0 = 0.f, a1 = 0.f, a2 = 0.f, a3 = 0.f;
#pragma unroll
    for (int i = 0; i < 16; i += 2) { a0 += d[i] * x[0][i]; a1 += d[i + 1] * x[0][i + 1]; a2 += d[16 + i] * x[1][i]; a3 += d[17 + i] * x[1][i + 1]; }
    return (a0 + a1) + (a2 + a3);
}
#define FP4X2(d, b) __builtin_amdgcn_cvt_scalef32_pk_f32_fp4((d), 1.0f, (b))
typedef __bf16 bf16x2v __attribute__((ext_vector_type(2)));
#define FP4BF2(d, b) __builtin_amdgcn_cvt_scalef32_pk_bf16_fp4((d), 1.0f, (b))
#define DOT2BF(a, xw, c) __builtin_amdgcn_fdot2_f32_bf16((a), __builtin_bit_cast(bf16x2v, (xw)), (c), false)
typedef int i32x8 __attribute__((ext_vector_type(8)));
constexpr float XQ_SCALE = 0.5f;
struct XQ3 { u32x4 q0, q1, q2; };
__device__ __forceinline__ i32x8 frag_fp4(const u32x4 w) { i32x8 a; a[0] = (int)w.x; a[1] = (int)w.y; a[2] = (int)w.z; a[3] = (int)w.w; a[4] = 0; a[5] = 0; a[6] = 0; a[7] = 0; return a; }
__device__ __forceinline__ float dot32_fp4(const u32x4 w, const XQ3& xq, int lane) {
    const i32x8 a = frag_fp4(w);
    f32x4 c = __builtin_amdgcn_mfma_scale_f32_16x16x128_f8f6f4(a, frag_fp4(xq.q0), (f32x4){0.f, 0.f, 0.f, 0.f}, 4, 4, 0, 0x7F7F7F7F, 0, 0x7F7F7F7F);
    c = __builtin_amdgcn_mfma_scale_f32_16x16x128_f8f6f4(a, frag_fp4(xq.q1), c, 4, 4, 0, 0x7F7F7F7F, 0, 0x7C7C7C7C);
    c = __builtin_amdgcn_mfma_scale_f32_16x16x128_f8f6f4(a, frag_fp4(xq.q2), c, 4, 4, 0, 0x7F7F7F7F, 0, 0x79797979);
    const float lo = (lane & 1) ? c[1] : c[0], hi = (lane & 1) ? c[3] : c[2], v = (lane & 2) ? hi : lo;
    return ((lane >> 4) == ((lane & 15) >> 2)) ? v : 0.f;
}
__device__ __forceinline__ void axpy32_fp4(const u32x4 w, float s, float (&acc)[2][16]) {
    const f32x2 ss = {s, s};
#pragma unroll
    for (int h = 0; h < 4; ++h) { const unsigned d = w[h]; const int j = h >> 1, e = 8 * (h & 1);
        const f32x2 t0 = (f32x2){acc[j][e], acc[j][e + 1]} + ss * FP4X2(d, 0), t1 = (f32x2){acc[j][e + 2], acc[j][e + 3]} + ss * FP4X2(d, 1),
                    t2 = (f32x2){acc[j][e + 4], acc[j][e + 5]} + ss * FP4X2(d, 2), t3 = (f32x2){acc[j][e + 6], acc[j][e + 7]} + ss * FP4X2(d, 3);
        acc[j][e] = t0[0]; acc[j][e + 1] = t0[1]; acc[j][e + 2] = t1[0]; acc[j][e + 3] = t1[1]; acc[j][e + 4] = t2[0]; acc[j][e + 5] = t2[1]; acc[j][e + 6] = t3[0]; acc[j][e + 7] = t3[1]; }
}
__device__ __forceinline__ void axpy32_fp6(const U3 w0, const U3 w1, float s, float (&acc)[2][16]) {
    const f32x32 d = dec32_fp6(w0, w1);
#pragma unroll
    for (int i = 0; i < 16; ++i) { acc[0][i] += s * d[i]; acc[1][i] += s * d[16 + i]; }
}
__device__ __forceinline__ void ln32_store(float (&y)[2][16], const float* gam, const float* bet, float* of32, bf16* ob16, int lane) {
    f32x4 gg[8], bb[8];
#pragma unroll
    for (int q = 0; q < 8; ++q) { const int e = 1024 * (q >> 2) + 16 * lane + 4 * (q & 3); gg[q] = *(const f32x4*)(gam + e); bb[q] = *(const f32x4*)(bet + e); }
    float s = 0.f;
#pragma unroll
    for (int j = 0; j < 2; ++j)
#pragma unroll
        for (int i = 0; i < 16; ++i) s += y[j][i];
    const float mean = wave_sum(s) * (1.f / DM); float q = 0.f;
#pragma unroll
    for (int j = 0; j < 2; ++j)
#pragma unroll
        for (int i = 0; i < 16; ++i) { y[j][i] -= mean; q += y[j][i] * y[j][i]; }
    const float rstd = frsq(wave_sum(q) * (1.f / DM) + LN_EPS);
#pragma unroll
    for (int j = 0; j < 2; ++j)
#pragma unroll
        for (int h8 = 0; h8 < 2; ++h8) { const int e = 1024 * j + 16 * lane + 8 * h8;
            const f32x4 g0 = gg[4 * j + 2 * h8], g1 = gg[4 * j + 2 * h8 + 1], b0 = bb[4 * j + 2 * h8], b1 = bb[4 * j + 2 * h8 + 1];
            f32x4 o0, o1;
#pragma unroll
            for (int i = 0; i < 4; ++i) { o0[i] = y[j][8 * h8 + i] * rstd * g0[i] + b0[i]; o1[i] = y[j][8 * h8 + 4 + i] * rstd * g1[i] + b1[i]; }
            if (of32) { *(f32x4*)(of32 + e) = o0; *(f32x4*)(of32 + e + 4) = o1; }
            if (ob16) *(u32x4*)(ob16 + e) = pack8(o0, o1); }
}
__device__ __forceinline__ void sort_picks128(int& k0, int& k1, float& g0, float& g1, int lane) {
#pragma unroll
    for (int k = 2; k <= 128; k <<= 1) {
#pragma unroll
        for (int j = k >> 1; j > 0; j >>= 1) {
            if (j == 64) { const bool sw = k0 > k1; const int tk = k0; const float tg = g0; k0 = sw ? k1 : k0; g0 = sw ? g1 : g0; k1 = sw ? tk : k1; g1 = sw ? tg : g1; }
            else {
                const bool lower = (lane & j) == 0;
                { const bool up = (lane & k) == 0; const int ok = __shfl_xor(k0, j); const float og = __shfl_xor(g0, j);
                  const bool take = (lower == up) ? (ok < k0) : (ok > k0); k0 = take ? ok : k0; g0 = take ? og : g0; }
                { const bool up = ((64 + lane) & k) == 0; const int ok = __shfl_xor(k1, j); const float og = __shfl_xor(g1, j);
                  const bool take = (lower == up) ? (ok < k1) : (ok > k1); k1 = take ? ok : k1; g1 = take ? og : g1; }
            }
        }
    }
}
__device__ __forceinline__ void sort_keys128_desc(unsigned& k0, unsigned& k1, int lane) {
#pragma unroll
    for (int k = 2; k <= 128; k <<= 1) {
#pragma unroll
        for (int j = k >> 1; j > 0; j >>= 1) {
            if (j == 64) { const bool sw = k0 < k1; const unsigned tk = k0; k0 = sw ? k1 : k0; k1 = sw ? tk : k1; }
            else {
                const bool lower = (lane & j) == 0;
                { const bool up = (lane & k) == 0; const unsigned ok = (unsigned)__shfl_xor((int)k0, j); const bool take = (lower == up) ? (ok > k0) : (ok < k0); k0 = take ? ok : k0; }
                { const bool up = ((64 + lane) & k) == 0; const unsigned ok = (unsigned)__shfl_xor((int)k1, j); const bool take = (lower == up) ? (ok > k1) : (ok < k1); k1 = take ? ok : k1; }
            }
        }
    }
}
__device__ __forceinline__ void peer_gather_phase(const Ctx& C, const InRef& I, int L, float* xout) {
    const bf16* X1B = (const bf16*)(C.ws + WS_X1B); const bf16* PLE = (const bf16*)(C.ws + WS_PW);
    const unsigned char* PU = C.ws + WS_PU; const unsigned char* PV = C.ws + WS_PV;
    const float* SU = (const float*)(C.ws + WS_SU); const float* SV = (const float*)(C.ws + WS_SV); const float* SV4 = (const float*)(C.ws + WS_SV4); const unsigned char* PV4 = C.ws + WS_PV4;
    const int* SELI = (const int*)(C.ws + WS_SELI); const float* SELG = (const float*)(C.ws + WS_SELG);
    bf16* XB = (bf16*)(C.ws + WS_XB);
    const int lane = C.lane;
    for (int m = C.gw; m < M; m += C.NGW) {
        unsigned xp[2][8];
#pragma unroll
        for (int j = 0; j < 2; ++j)
#pragma unroll
            for (int q = 0; q < 2; ++q) { const u32x4 v = *(const u32x4*)(X1B + (size_t)m * DM + 1024 * j + 16 * lane + 8 * q); xp[j][4 * q] = v.x; xp[j][4 * q + 1] = v.y; xp[j][4 * q + 2] = v.z; xp[j][4 * q + 3] = v.w; }
        XQ3 xq;
#pragma unroll
        for (int d = 0; d < 4; ++d) { unsigned w0 = 0u, w1 = 0u, w2 = 0u;
#define XQ_PAIR(bsel) { const unsigned p_ = xp[d >> 1][4 * (d & 1) + (bsel)]; const float y0 = bflo(p_) * XQ_SCALE, y1 = bfhi(p_) * XQ_SCALE; \
            w0 = __builtin_amdgcn_cvt_scalef32_pk_fp4_f32(w0, y0, y1, 1.0f, (bsel)); const f32x2 a0_ = __builtin_amdgcn_cvt_scalef32_pk_f32_fp4(w0, 1.0f, (bsel)); \
            const float r0 = (y0 - a0_[0]) * 8.f, r1 = (y1 - a0_[1]) * 8.f; \
            w1 = __builtin_amdgcn_cvt_scalef32_pk_fp4_f32(w1, r0, r1, 1.0f, (bsel)); const f32x2 a1_ = __builtin_amdgcn_cvt_scalef32_pk_f32_fp4(w1, 1.0f, (bsel)); \
            w2 = __builtin_amdgcn_cvt_scalef32_pk_fp4_f32(w2, (r0 - a1_[0]) * 8.f, (r1 - a1_[1]) * 8.f, 1.0f, (bsel)); }
            XQ_PAIR(0) XQ_PAIR(1) XQ_PAIR(2) XQ_PAIR(3)
#undef XQ_PAIR
            xq.q0[d] = w0; xq.q1[d] = w1; xq.q2[d] = w2; }
        u32x4 plv[2][2];
#pragma unroll
        for (int j = 0; j < 2; ++j) { const bf16* pp = PLE + (size_t)m * DM + 1024 * j + 16 * lane; plv[j][0] = *(const u32x4*)pp; plv[j][1] = *(const u32x4*)(pp + 8); }
        float acc[2][16];
#pragma unroll
        for (int j = 0; j < 2; ++j)
#pragma unroll
            for (int i = 0; i < 16; ++i) acc[j][i] = 0.f;
        const int sk0 = SELI[(size_t)m * 128 + lane], sk1 = SELI[(size_t)m * 128 + 64 + lane]; const float sg0 = SELG[(size_t)m * 128 + lane], sg1 = SELG[(size_t)m * 128 + 64 + lane];
        float b0 = 0.f, b1 = 0.f;
#pragma unroll 1
        for (int half = 0; half < 2; ++half) {
            const int eidx = half ? sk1 : sk0; const float eg = half ? sg1 : sg0;
            const float su = SU[eidx];
            float r16[16]; u32x4 ua, ub, uc, ud, ue, uf, ug, uh; const bool b0_ = (lane & 1) != 0, b1_ = (lane & 2) != 0;
#define GU_LDX(A, k) { const int id_ = __builtin_amdgcn_readlane(eidx, (k)); A = *(const u32x4*)(PU + (size_t)id_ * P4ROW + 16 * lane); }
#define GU_DOT(A) dot32_fp4(A, xq, lane)
            GU_LDX(ua, 0) GU_LDX(ub, 1) GU_LDX(uc, 2) GU_LDX(ud, 3) GU_LDX(ue, 4) GU_LDX(uf, 5) GU_LDX(ug, 6) GU_LDX(uh, 7)
#pragma unroll
            for (int e = 0; e < 64; e += 8) {
#define GU_FOUR(A, B, C_, D, o_) { const float p0 = GU_DOT(A); if (e + (o_) + 8 < 64) GU_LDX(A, e + (o_) + 8) const float p1 = GU_DOT(B); if (e + (o_) + 9 < 64) GU_LDX(B, e + (o_) + 9) \
                const float q0 = (b0_ ? p1 : p0) + __shfl_xor(b0_ ? p0 : p1, 1); \
                const float p2 = GU_DOT(C_); if (e + (o_) + 10 < 64) GU_LDX(C_, e + (o_) + 10) const float p3 = GU_DOT(D); if (e + (o_) + 11 < 64) GU_LDX(D, e + (o_) + 11) \
                const float q1 = (b0_ ? p3 : p2) + __shfl_xor(b0_ ? p2 : p3, 1); \
                r16[(e + (o_)) >> 2] = (b1_ ? q1 : q0) + __shfl_xor(b1_ ? q0 : q1, 2); }
                GU_FOUR(ua, ub, uc, ud, 0) GU_FOUR(ue, uf, ug, uh, 4)
#undef GU_FOUR
            }
#undef GU_DOT
#undef GU_LDX
#pragma unroll
            for (int j = 2, n = 8; j < 6; ++j, n >>= 1) { const bool up = ((lane >> j) & 1) != 0;
#pragma unroll
                for (int k = 0; k < n; ++k) { const float a = r16[2 * k], b = r16[2 * k + 1]; r16[k] = (up ? b : a) + __shfl_xor(up ? a : b, 1 << j); } }
            const float dot = r16[0] * su * (1.f / XQ_SCALE);
            const float act = pg8::gelu_pk((f32x2){dot, dot})[0];
            b0 = half ? b0 : eg * act; b1 = half ? eg * act : b1;
        }
        const int ri0 = sk0, ri1 = sk1; const float w0 = b0 * SV4[sk0], w1 = b1 * SV4[sk1];
        { u32x4 va, vb, vc, vd, ve, vf, vg, vh;
#define GB_LDX(RI, A, k) { const int id_ = __builtin_amdgcn_readlane(RI, (k)); A = *(const u32x4*)(PV4 + (size_t)id_ * P4ROW + 16 * lane); }
#define GB_AX(WW, A, k) { const float w_ = __builtin_bit_cast(float, __builtin_amdgcn_readlane(__builtin_bit_cast(int, WW), (k))); axpy32_fp4(A, w_, acc); }
#define GB_STEP(RI, WW, HI, A, o_) GB_AX(WW, A, e + (o_)) GB_LDX(RI, A, e + (o_) + 8 < (HI) - 1 ? e + (o_) + 8 : (HI) - 1)
#define GB_LOOP(RI, WW, LO, HI) { GB_LDX(RI, va, (LO)) GB_LDX(RI, vb, (LO) + 1) GB_LDX(RI, vc, (LO) + 2) GB_LDX(RI, vd, (LO) + 3) GB_LDX(RI, ve, (LO) + 4) GB_LDX(RI, vf, (LO) + 5) GB_LDX(RI, vg, (LO) + 6) GB_LDX(RI, vh, (LO) + 7) \
            _Pragma("unroll 1") for (int e = (LO); e < (HI); e += 8) { GB_STEP(RI, WW, HI, va, 0) GB_STEP(RI, WW, HI, vb, 1) GB_STEP(RI, WW, HI, vc, 2) GB_STEP(RI, WW, HI, vd, 3) GB_STEP(RI, WW, HI, ve, 4) GB_STEP(RI, WW, HI, vf, 5) GB_STEP(RI, WW, HI, vg, 6) GB_STEP(RI, WW, HI, vh, 7) } }
            GB_LOOP(ri0, w0, 0, 64)
            GB_LOOP(ri1, w1, 0, 64)
#undef GB_LOOP
#undef GB_STEP
#undef GB_LDX
#undef GB_AX
        }
#pragma unroll
        for (int j = 0; j < 2; ++j) { const u32x4 p0 = plv[j][0], p1 = plv[j][1];
            const float pl[16] = {bflo(p0.x), bfhi(p0.x), bflo(p0.y), bfhi(p0.y), bflo(p0.z), bfhi(p0.z), bflo(p0.w), bfhi(p0.w), bflo(p1.x), bfhi(p1.x), bflo(p1.y), bfhi(p1.y), bflo(p1.z), bfhi(p1.z), bflo(p1.w), bfhi(p1.w)};
#pragma unroll
            for (int i = 0; i < 16; ++i) acc[j][i] += ALPHA * ((i & 1) ? bfhi(xp[j][i >> 1]) : bflo(xp[j][i >> 1])) + pl[i]; }
        ln32_store(acc, I.in(25) + (size_t)L * DM, I.in(26) + (size_t)L * DM, xout ? xout + (size_t)m * DM : (float*)nullptr, xout ? (bf16*)nullptr : XB + (size_t)m * DM, lane);
    }
}

struct Args { InPtrs I; float* out; unsigned char* ws; int ph_lo, ph_hi, dry, pad; };
constexpr int PH_PER_LAYER = 10, N_PHASES = DEPTH * PH_PER_LAYER;

__global__ void __launch_bounds__(NTHR, 2) mk_fwd(Args args) {
    extern __shared__ __attribute__((aligned(16))) unsigned char lds_raw[];
    Ctx C;
    C.lds = (LAS unsigned char*)lds_raw; C.ws = (unsigned char*)(GAS unsigned char*)args.ws; C.ctl = (gu32*)(C.ws + WS_CTL);
    C.tid = threadIdx.x; C.lane = C.tid & 63; C.wave = __builtin_amdgcn_readfirstlane(C.tid >> 6);
    C.G = gridDim.x; C.bid = blockIdx.x; C.gw = blockIdx.x * NWAVES + C.wave; C.NGW = C.G * NWAVES;
    volatile LAS unsigned* MISC = (volatile LAS unsigned*)(C.lds + MISC_OFF);
    for (int u = C.tid; u < (LDS_BYTES - 131072) / 4; u += NTHR) ((LAS unsigned*)(C.lds + 131072))[u] = 0u;
    __syncthreads();
    XcdBarrier bar = xcd_barrier_post((unsigned*)(C.ctl + CW_BAR), MISC + 8);
    const int lo = args.ph_lo, hi = args.ph_hi;
    LAS unsigned char* ring = C.lds;

    for (int L = 0; L < DEPTH; ++L) {
        const int pb = L * PH_PER_LAYER;
#ifndef PHMASK
#define PHMASK 0x3ff
#endif
#define IN(k) (((PHMASK >> (k)) & 1) && lo <= pb + (k) && pb + (k) < hi)
#define SEAM(k) do { if (pb + (k) + 1 < hi) xcd_barrier(bar); } while (0)
#define XRES() ((L == 0) ? I.in(0) : (const float*)nullptr)
#define B_IN() (I.in(3) + (size_t)L * IN_TOTAL)

        if (IN(0)) { const Ctx P = fresh_ctx(C); const InRef I = fresh_in(); prologue_phase(P, I, L, XRES()); SEAM(0); }

        if (IN(1)) { const Ctx P = fresh_ctx(C); const InRef I = fresh_in(); const float* b_in = B_IN();
            if (P.bid < 16 && P.wave == 0) cumsum_seq(P, P.bid);
            __syncthreads();
#ifndef SUBMASK
#define SUBMASK 7
#endif
            if (SUBMASK & 1) { pg8::Gemm g{(const bf16*)(P.ws + WS_XB8), (const bf16*)(P.ws + WS_WIN), M, NIN, DM / 2, 0, 0}; pg8::StaticOrder S; S.init(M, NIN, P.G, P.bid);
              EpiInProj E{P.ws, b_in, 0};
              pg8::gemm_phase<EpiInProj, pg8::StaticOrder, true, true, true>(ring, g, S, E); }
            if (SUBMASK & 2) { pg8::Gemm g{(const bf16*)(P.ws + WS_WV), (const bf16*)(P.ws + WS_XB8), 2048, M, DM / 2, 0, 0}; pg8::StaticOrder S; S.init(2048, M, P.G, P.bid);
              EpiVT E{(bf16*)(P.ws + WS_VT), b_in};
              pg8::gemm_phase<EpiVT, pg8::StaticOrder, true, true, true, 0x7F, 0x79>(ring, g, S, E); }
            SEAM(1);
        }

        if (IN(2)) {
            for (int u = blockIdx.x; u < BATCH * LRU_NCH * 8; u += C.G) { const Ctx P = fresh_ctx(C); const InRef I = fresh_in(); lru_unit<false>(P, I, L, u, nullptr); }
            { const Ctx P = fresh_ctx(C); kmax_phase(P, L); }
            SEAM(2);
        }

        if (IN(3)) {
#ifndef PROBE_SUB
#define PROBE_SUB 7
#endif
            const int dry = args.dry; const int subm = dry ? PROBE_SUB : 7; gu32* qh = C.ctl + CW_QUEUE + 64 * (L * 3) + (dry ? 64 * 8 : 0);
            if (subm & 1) { const int myx = (int)(bar.x & 7u); gu32* qx = C.ctl + CW_QUEUE + 2048 + 1024 * L + (dry ? 512 : 0);
              for (int qq = 0; qq < 8; ++qq) { const int xq = (myx + qq) & 7;
                for (;;) { __syncthreads(); if (C.tid == 0) MISC[16] = __hip_atomic_fetch_add(qx + 64 * xq, 1u, RLX_AGENT); __syncthreads();
                    const int idx = (int)MISC[16]; if (idx >= 128) break;
                    const int qb = 63 - (idx >> 1), bh = 2 * xq + (idx & 1); const Ctx P = fresh_ctx(C); const InRef I = fresh_in(); attn_diff_unit(P, I, L, bh >> 3, bh & 7, qb, P.ws + WS_Y3); } } }
            if (subm & 2) for (;;) { __syncthreads(); if (C.tid == 0) MISC[16] = __hip_atomic_fetch_add(qh + 64, 1u, RLX_AGENT); __syncthreads();
                const int idx = (int)MISC[16]; if (idx >= 512) break;
                const int qb = 31 - (idx >> 4), bh = idx & 15; const Ctx P = fresh_ctx(C); const InRef I = fresh_in(); attn_unit<1>(P, I, L, bh >> 3, bh & 7, qb, P.ws + WS_Y3 + 2048); }
            if (subm & 4) for (;;) { __syncthreads(); if (C.tid == 0) MISC[16] = __hip_atomic_fetch_add(qh + 128, 1u, RLX_AGENT); __syncthreads();
                const int idx = (int)MISC[16]; if (idx >= BATCH * LRU_NCH * 8) break;
                const Ctx P = fresh_ctx(C); const InRef I = fresh_in(); lru_final_unit(P, idx, P.ws + WS_Y3 + 1024); }
            SEAM(3);
        }

        if (IN(4)) { const Ctx P = fresh_ctx(C);
            pg8::Gemm g{(const bf16*)(P.ws + WS_Y3), (const bf16*)(P.ws + WS_WBR), M, DM, 1536, 0, 0}; pg8::StaticOrder S; S.init(M, DM, P.G, P.bid);
            EpiMerge E{(const bf16*)(P.ws + WS_G), (bf16*)(P.ws + WS_X1B)};
            pg8::gemm_phase<EpiMerge, pg8::StaticOrder, true, true, true, 0x79, 0x7C>(ring, g, S, E);
            SEAM(4);
        }

        if (IN(5)) { const Ctx P = fresh_ctx(C); const InRef I = fresh_in(); const bf16* xres = (const bf16*)(P.ws + WS_XB);
            if (SUBMASK & 1) { pg8::Gemm g{(const bf16*)(P.ws + WS_PB), (const bf16*)(P.ws + WS_WPLE), M, DM, 256, 0, 0}; pg8::StaticOrder S; S.init(M, DM, P.G, P.bid);
              EpiPlain E{(bf16*)(P.ws + WS_PW), DM};
              pg8::gemm_phase<EpiPlain, pg8::StaticOrder, true, true>(ring, g, S, E); }
            if (SUBMASK & 2) { pg8::Gemm g{(const bf16*)(P.ws + WS_X1B), (const bf16*)(P.ws + WS_WO), M, DM, DM / 2, 0, 0}; pg8::StaticOrder S; S.init(M, DM, P.G, P.bid);
              EpiWo E{xres, (bf16*)(P.ws + WS_YB)};
              pg8::gemm_phase<EpiWo, pg8::StaticOrder, true, true, true, 0x79, 0x7C>(ring, g, S, E); }
            SEAM(5);
        }

        if (IN(6)) { const Ctx P = fresh_ctx(C); const InRef I = fresh_in(); ln1_phase(P, I, L, args.dry); SEAM(6); }

        if (IN(7)) { const Ctx P = fresh_ctx(C); const InRef I = fresh_in();
            { pg8::Gemm g{(const bf16*)(P.ws + WS_X1B8), (const bf16*)(P.ws + WS_WPGQ), M, 2048, DM / 2, 0, 0}; pg8::StaticOrder S; S.init(M, 2048, P.G, P.bid);
              EpiPgq E{(bf16*)(P.ws + WS_PW), (bf16*)(P.ws + WS_PQ), I.in(24) + (size_t)L * DM, (bf16*)(P.ws + WS_PW), 0};
              pg8::gemm_phase<EpiPgq, pg8::StaticOrder, true, true, true>(ring, g, S, E); }
            { pg8::Gemm g{(const bf16*)(P.ws + WS_X1B), (const bf16*)(P.ws + WS_WPGQ) + (size_t)2048 * DM, M, 1024, DM, 0, 0}; pg8::StaticOrder S; S.init(M, 1024, P.G, P.bid);
              EpiPgq E{(bf16*)(P.ws + WS_PW), (bf16*)(P.ws + WS_PQ), I.in(24) + (size_t)L * DM, (bf16*)(P.ws + WS_PW), 8};
              pg8::gemm_phase<EpiPgq, pg8::StaticOrder, true, true>(ring, g, S, E); }
            SEAM(7);
        }

        if (IN(8)) { const Ctx P = fresh_ctx(C); peer_select_phase(P); SEAM(8); }

        if (IN(9)) { const Ctx P = fresh_ctx(C); const InRef I = fresh_in(); peer_gather_phase(P, I, L, L == DEPTH - 1 ? (float*)(GAS float*)args.out : (float*)nullptr); SEAM(9); }
#undef IN
#undef SEAM
    }
}

extern "C" void kernel_launch(void* const* d_in, const int* in_sizes, int n_in, void* d_out, int out_size, void* d_ws, size_t ws_size, hipStream_t stream) {
    static int grid = 0;
    if (grid == 0) {
        if (n_in != 27 || in_sizes[0] != M * DM || out_size != M * DM || ws_size < WS_END) {
            fprintf(stderr, "kernel_launch: unexpected shapes (n_in %d, in0 %d, out %d, ws %zu); nothing launched\n", n_in, n_in > 0 ? in_sizes[0] : -1, out_size, ws_size); grid = -1; return; }
        int dev = 0, cus = 0, per_cu = 0;
        if (hipGetDevice(&dev) != hipSuccess || hipDeviceGetAttribute(&cus, hipDeviceAttributeMultiprocessorCount, dev) != hipSuccess) { grid = -1; return; }
        if (hipFuncSetAttribute((const void*)mk_fwd, hipFuncAttributeMaxDynamicSharedMemorySize, LDS_BYTES) != hipSuccess) { fprintf(stderr, "kernel_launch: hipFuncSetAttribute failed\n"); grid = -1; return; }
        if (hipOccupancyMaxActiveBlocksPerMultiprocessor(&per_cu, (const void*)mk_fwd, NTHR, LDS_BYTES) != hipSuccess || per_cu < 1) { fprintf(stderr, "kernel_launch: occupancy query reports %d\n", per_cu); }
        (void)hipGetLastError();
        grid = cus;
    }
    if (grid < 0) return;
    if (hipMemsetAsync((char*)d_ws + WS_CTL, 0, CTL_ZERO_BYTES, stream) != hipSuccess) return;
    Args a{};
    for (int i = 0; i < 27; ++i) a.I.in[i] = (const float*)d_in[i];
    a.out = (float*)d_out; a.ws = (unsigned char*)d_ws;
#if MK_MULTI
#ifndef PROBE_MASK
#define PROBE_MASK 0
#endif
    for (int p = 0; p < N_PHASES; ++p) { a.ph_lo = p; a.ph_hi = p + 1;
        if ((PROBE_MASK >> (p % PH_PER_LAYER)) & 1) { a.dry = 1; hipLaunchKernelGGL(mk_fwd, dim3(grid), dim3(NTHR), LDS_BYTES, stream, a); }
        a.dry = 0; hipLaunchKernelGGL(mk_fwd, dim3(grid), dim3(NTHR), LDS_BYTES, stream, a); }
#else
    a.ph_lo = 0; a.ph_hi = N_PHASES; a.dry = 0;
    hipLaunchKernelGGL(mk_fwd, dim3(grid), dim3(NTHR), LDS_BYTES, stream, a);
#endif
    const hipError_t le = hipPeekAtLastError();
    if (le != hipSuccess) fprintf(stderr, "kernel_launch: launch failed: %s\n", hipGetErrorName(le));
}
```
